# Optimizing an MI355X kernel written in HIP

```python
import math
import jax, jax.numpy as jnp
from jax import lax
import numpy as np

D_MODEL = 1024
BATCH = 16
SEQ = 2048
DEPTH = 2

A_HEADS = 8
A_HEAD_DIM = 64
A_WIDTH = A_HEADS * A_HEAD_DIM
A_DECAY_LORA = 64
A_ICLR_LORA = 64
A_GATE_LORA = 128
A_PROJ = 3 * A_WIDTH + A_DECAY_LORA + A_ICLR_LORA + A_GATE_LORA
A_GN_EPS = 64e-5

B_HEADS = 4
B_QK_DIM = 128
B_V_DIM = 256
B_QK_WIDTH = B_HEADS * B_QK_DIM
B_V_WIDTH = B_HEADS * B_V_DIM
B_CHUNK = 128
B_ROPE_BASE = 10000.0
B_GN_EPS = 1e-5

C_WIDTH = 512
C_GROUP = 16
C_GROUPS = C_WIDTH // C_GROUP
C_STATE = 64
C_DT_MIN = 1e-3
C_DT_MAX = 1e-1

PROJ_TOTAL = A_PROJ + 2 * B_QK_WIDTH + 2 * B_V_WIDTH + C_WIDTH + 3 * D_MODEL
PROJ_SPLITS = (A_PROJ,
               A_PROJ + B_QK_WIDTH,
               A_PROJ + 2 * B_QK_WIDTH,
               A_PROJ + 2 * B_QK_WIDTH + B_V_WIDTH,
               A_PROJ + 2 * B_QK_WIDTH + 2 * B_V_WIDTH,
               A_PROJ + 2 * B_QK_WIDTH + 2 * B_V_WIDTH + C_WIDTH)
A_SPLITS = (A_WIDTH, 2 * A_WIDTH, 3 * A_WIDTH,
            3 * A_WIDTH + A_DECAY_LORA, 3 * A_WIDTH + A_DECAY_LORA + A_ICLR_LORA)
BRANCH_ROWS = A_WIDTH + B_V_WIDTH + C_WIDTH

D_FF = 4 * D_MODEL
DN_ALPHA = (2.0 * DEPTH) ** 0.25
DN_BETA = (8.0 * DEPTH) ** -0.25
LN_EPS = 1e-5

kernel_name = 'hybrid_rwkv7_retnet_s5_deepnorm'


def _layer_norm(x, g, b):
    xf = x.astype(jnp.float32)
    mu = xf.mean(-1, keepdims=True)
    var = jnp.square(xf - mu).mean(-1, keepdims=True)
    y = (xf - mu) * lax.rsqrt(var + LN_EPS)
    return (y * g.astype(jnp.float32) + b.astype(jnp.float32)).astype(x.dtype)


def _group_norm(x, eps):
    xf = x.astype(jnp.float32)
    mu = xf.mean(-1, keepdims=True)
    var = jnp.square(xf - mu).mean(-1, keepdims=True)
    return (xf - mu) * lax.rsqrt(var + eps)


def _token_shift(z, mu):
    prev = jnp.pad(z, ((0, 0), (1, 0), (0, 0)))[:, :-1]
    return z + mu * (prev - z)


def _rwkv7_mixer(z, w0, w2, a0, a2, g2, k_k, k_a, r_k, lnx_g, lnx_b):
    bsz, seq, _ = z.shape
    r, k, v, zw, za, zg = jnp.split(z, A_SPLITS, axis=-1)
    w_ll = -jax.nn.softplus(-(w0 + jnp.tanh(zw) @ w2)) - 0.5
    a = jax.nn.sigmoid(a0 + za @ a2)
    g = jax.nn.sigmoid(zg) @ g2
    heads = lambda t: t.reshape(bsz, seq, A_HEADS, A_HEAD_DIM).astype(jnp.float32)
    r, k, v, a, w_ll = heads(r), heads(k), heads(v), heads(a), heads(w_ll)
    kk = k * k_k.astype(jnp.float32)
    kk = kk / jnp.maximum(jnp.sqrt(jnp.sum(kk * kk, -1, keepdims=True)), 1e-12)
    k = k * (1.0 + (a - 1.0) * k_a.astype(jnp.float32))
    decay = jnp.exp(-jnp.exp(w_ll))

    def step(state, inp):
        r_t, w_t, k_t, v_t, na_t, nb_t = inp
        sa = jnp.einsum('bhvk,bhk->bhv', state, na_t)
        state = (state * w_t[:, :, None, :] + sa[..., None] * nb_t[:, :, None, :]
                 + v_t[..., None] * k_t[:, :, None, :])
        return state, jnp.einsum('bhvk,bhk->bhv', state, r_t)

    xs = tuple(jnp.moveaxis(t, 1, 0) for t in (r, decay, k, v, -kk, kk * a))
    s0 = jnp.zeros((bsz, A_HEADS, A_HEAD_DIM, A_HEAD_DIM), jnp.float32)
    _, o = lax.scan(step, s0, xs)
    o = jnp.moveaxis(o, 0, 1)
    o = _group_norm(o, A_GN_EPS) * lnx_g.astype(jnp.float32) + lnx_b.astype(jnp.float32)
    o = o + jnp.sum(r * k * r_k.astype(jnp.float32), -1, keepdims=True) * v
    return (o.reshape(bsz, seq, A_WIDTH) * g.astype(jnp.float32)).astype(z.dtype)


def _rope(t, cos, sin):
    t1, t2 = jnp.split(t, 2, axis=-1)
    return jnp.concatenate([t1 * cos - t2 * sin, t2 * cos + t1 * sin], axis=-1)


def _retention_mixer(q, k, v, g):
    bsz, seq, _ = q.shape
    n_chunks = seq // B_CHUNK
    f32 = jnp.float32
    pos = jnp.arange(seq, dtype=f32)
    half = B_QK_DIM // 2
    inv_freq = B_ROPE_BASE ** (-jnp.arange(half, dtype=f32) / half)
    ang = pos[:, None] * inv_freq[None, :]
    cos, sin = jnp.cos(ang)[:, None, :], jnp.sin(ang)[:, None, :]
    q = _rope(q.reshape(bsz, seq, B_HEADS, B_QK_DIM).astype(f32), cos, sin)
    k = _rope(k.reshape(bsz, seq, B_HEADS, B_QK_DIM).astype(f32), cos, sin) * (B_QK_DIM ** -0.5)
    v = v.reshape(bsz, seq, B_HEADS, B_V_DIM).astype(f32)
    log_gamma = jnp.log(1.0 - 2.0 ** (-5.0 - jnp.arange(B_HEADS, dtype=f32)))
    idx = jnp.arange(B_CHUNK, dtype=f32)
    rel = idx[:, None] - idx[None, :]
    inner_decay = jnp.where(rel >= 0, jnp.exp(log_gamma[:, None, None] * jnp.maximum(rel, 0.0)), 0.0)
    q_decay = jnp.exp(log_gamma[:, None] * (idx + 1.0))
    k_decay = jnp.exp(log_gamma[:, None] * (B_CHUNK - 1.0 - idx))
    chunk_decay = jnp.exp(log_gamma * B_CHUNK)
    to_chunks = lambda t: t.reshape(bsz, n_chunks, B_CHUNK, B_HEADS, t.shape[-1])
    qc, kc, vc = to_chunks(q), to_chunks(k), to_chunks(v)
    scores = jnp.einsum('bnihd,bnjhd->bnhij', qc, kc) * inner_decay
    inner = jnp.einsum('bnhij,bnjhe->bnihe', scores, vc)
    upd = jnp.einsum('bnjhd,hj,bnjhe->nbhde', kc, k_decay, vc)

    def step(state, u_n):
        return chunk_decay[None, :, None, None] * state + u_n, state

    r0 = jnp.zeros((bsz, B_HEADS, B_QK_DIM, B_V_DIM), f32)
    _, r_prev = lax.scan(step, r0, upd)
    cross = jnp.einsum('bnihd,hi,nbhde->bnihe', qc, q_decay, r_prev)
    o = (inner + cross).reshape(bsz, seq, B_HEADS, B_V_DIM)
    o = _group_norm(o, B_GN_EPS).reshape(bsz, seq, B_V_WIDTH)
    return (jax.nn.silu(g.astype(f32)) * o).astype(g.dtype)


def _s5_mixer(u, lam_re, lam_im, log_dt, b_re, b_im, c_re, c_im, d_skip, w_glu, b_glu):
    bsz, seq, _ = u.shape
    f32 = jnp.float32
    uf = u.reshape(bsz, seq, C_GROUPS, C_GROUP).astype(f32)
    dt = jnp.exp(log_dt.astype(f32))[:, None]
    lr, li = lam_re.astype(f32), lam_im.astype(f32)
    mag = jnp.exp(lr * dt)
    ab_re, ab_im = mag * jnp.cos(li * dt), mag * jnp.sin(li * dt)
    den = lr * lr + li * li
    f_re = ((ab_re - 1.0) * lr + ab_im * li) / den
    f_im = (ab_im * lr - (ab_re - 1.0) * li) / den
    bre, bim = b_re.astype(f32), b_im.astype(f32)
    bb_re = f_re[..., None] * bre - f_im[..., None] * bim
    bb_im = f_re[..., None] * bim + f_im[..., None] * bre
    bu_re = jnp.einsum('gpc,bsgc->bsgp', bb_re, uf)
    bu_im = jnp.einsum('gpc,bsgc->bsgp', bb_im, uf)
    a_re = jnp.broadcast_to(ab_re, (1, seq, C_GROUPS, C_STATE))
    a_im = jnp.broadcast_to(ab_im, (1, seq, C_GROUPS, C_STATE))

    def combine(e1, e2):
        a1r, a1i, b1r, b1i = e1
        a2r, a2i, b2r, b2i = e2
        return (a2r * a1r - a2i * a1i, a2r * a1i + a2i * a1r,
                a2r * b1r - a2i * b1i + b2r, a2r * b1i + a2i * b1r + b2i)

    _, _, x_re, x_im = lax.associative_scan(combine, (a_re, a_im, bu_re, bu_im), axis=1)
    y = (jnp.einsum('gcp,bsgp->bsgc', c_re.astype(f32), x_re)
         - jnp.einsum('gcp,bsgp->bsgc', c_im.astype(f32), x_im)
         + d_skip.astype(f32) * uf)
    y = jax.nn.gelu(y.reshape(bsz, seq, C_WIDTH))
    y = y * jax.nn.sigmoid(y @ w_glu.astype(f32) + b_glu.astype(f32))
    return y.astype(u.dtype)


def setup_inputs(seed: int = 0) -> dict:
    key = jax.random.key(seed)
    ks = iter(jax.random.split(key, 40))
    f32 = jnp.float32
    nrm = lambda shape, scale: scale * jax.random.normal(next(ks), shape, f32)
    L, D = DEPTH, D_MODEL
    ratio = jnp.linspace(0.0, 1.0, A_WIDTH, dtype=f32)
    branch_scale = jnp.concatenate([
        jnp.full((A_WIDTH,), A_WIDTH ** -0.5, f32),
        jnp.full((B_V_WIDTH,), B_V_WIDTH ** -0.5, f32),
        jnp.full((C_WIDTH,), C_WIDTH ** -0.5, f32)])[:, None]
    lam_im0 = math.pi * jnp.arange(C_STATE, dtype=f32)
    return {
        'x': nrm((BATCH, SEQ, D), 1.0),
        'w_in': nrm((L, D, PROJ_TOTAL), D ** -0.5),
        'b_gate': nrm((L, 3 * D), 0.02),
        'a_shift': jax.random.uniform(next(ks), (L, A_PROJ), f32),
        'a_w0': -5.5 + 5.0 * ratio ** 0.85 + nrm((L, A_WIDTH), 0.1),
        'a_w2': nrm((L, A_DECAY_LORA, A_WIDTH), 0.1 * A_DECAY_LORA ** -0.5),
        'a_a0': nrm((L, A_WIDTH), 0.1),
        'a_a2': nrm((L, A_ICLR_LORA, A_WIDTH), 0.1 * A_ICLR_LORA ** -0.5),
        'a_g2': nrm((L, A_GATE_LORA, A_WIDTH), A_GATE_LORA ** -0.5),
        'a_kk': 0.85 + nrm((L, A_HEADS, A_HEAD_DIM), 0.02),
        'a_ka': 1.0 + nrm((L, A_HEADS, A_HEAD_DIM), 0.02),
        'a_rk': nrm((L, A_HEADS, A_HEAD_DIM), 0.1),
        'a_lnx_g': 1.0 + nrm((L, A_HEADS, A_HEAD_DIM), 0.02),
        'a_lnx_b': nrm((L, A_HEADS, A_HEAD_DIM), 0.02),
        'c_lam_re': -0.5 + nrm((L, C_GROUPS, C_STATE), 0.01),
        'c_lam_im': lam_im0 + nrm((L, C_GROUPS, C_STATE), 0.01),
        'c_log_dt': jax.random.uniform(next(ks), (L, C_GROUPS), f32,
                                       math.log(C_DT_MIN), math.log(C_DT_MAX)),
        'c_b_re': nrm((L, C_GROUPS, C_STATE, C_GROUP), (2.0 * C_GROUP) ** -0.5),
        'c_b_im': nrm((L, C_GROUPS, C_STATE, C_GROUP), (2.0 * C_GROUP) ** -0.5),
        'c_c_re': nrm((L, C_GROUPS, C_GROUP, C_STATE), C_STATE ** -0.5),
        'c_c_im': nrm((L, C_GROUPS, C_GROUP, C_STATE), C_STATE ** -0.5),
        'c_d': nrm((L, C_GROUPS, C_GROUP), 1.0),
        'c_w_glu': nrm((L, C_WIDTH, C_WIDTH), C_WIDTH ** -0.5),
        'c_b_glu': nrm((L, C_WIDTH), 0.02),
        'w_branch': nrm((L, BRANCH_ROWS, D), 1.0) * branch_scale,
        'w_out': nrm((L, D, D), DN_BETA * D ** -0.5),
        'ln1_g': 1.0 + nrm((L, D), 0.02),
        'ln1_b': nrm((L, D), 0.02),
        'w_ff1': nrm((L, D, D_FF), D ** -0.5),
        'w_ff2': nrm((L, D_FF, D), DN_BETA * D_FF ** -0.5),
        'ln2_g': 1.0 + nrm((L, D), 0.02),
        'ln2_b': nrm((L, D), 0.02),
    }


def reference(x, w_in, b_gate, a_shift, a_w0, a_w2, a_a0, a_a2, a_g2, a_kk, a_ka, a_rk,
              a_lnx_g, a_lnx_b, c_lam_re, c_lam_im, c_log_dt, c_b_re, c_b_im, c_c_re,
              c_c_im, c_d, c_w_glu, c_b_glu, w_branch, w_out, ln1_g, ln1_b, w_ff1, w_ff2,
              ln2_g, ln2_b):
    for l in range(DEPTH):
        proj = x @ w_in[l]
        z_a, q_b, k_b, v_b, g_b, u_c, gate_logits = jnp.split(proj, PROJ_SPLITS, axis=-1)
        z_a = _token_shift(z_a, a_shift[l])
        y_a = _rwkv7_mixer(z_a, a_w0[l], a_w2[l], a_a0[l], a_a2[l], a_g2[l],
                           a_kk[l], a_ka[l], a_rk[l], a_lnx_g[l], a_lnx_b[l])
        y_b = _retention_mixer(q_b, k_b, v_b, g_b)
        y_c = _s5_mixer(u_c, c_lam_re[l], c_lam_im[l], c_log_dt[l], c_b_re[l], c_b_im[l],
                        c_c_re[l], c_c_im[l], c_d[l], c_w_glu[l], c_b_glu[l])
        wb_a, wb_b, wb_c = jnp.split(w_branch[l], (A_WIDTH, A_WIDTH + B_V_WIDTH), axis=0)
        gate_a, gate_b, gate_c = jnp.split(jax.nn.sigmoid(gate_logits + b_gate[l]), 3, axis=-1)
        merged = gate_a * (y_a @ wb_a) + gate_b * (y_b @ wb_b) + gate_c * (y_c @ wb_c)
        x = _layer_norm(DN_ALPHA * x + merged @ w_out[l], ln1_g[l], ln1_b[l])
        ff = jnp.square(jax.nn.relu(x @ w_ff1[l])) @ w_ff2[l]
        x = _layer_norm(DN_ALPHA * x + ff, ln2_g[l], ln2_b[l])
    return x
```

```cpp
#include <hip/hip_runtime.h>
#include <hip/hip_cooperative_groups.h>
#include <cstdio>
#include <cstdint>
namespace cg = cooperative_groups;

#define LAS __attribute__((address_space(3)))
typedef unsigned short bf16_t;
typedef short bf16x8 __attribute__((ext_vector_type(8)));
typedef float f32x4 __attribute__((ext_vector_type(4)));
typedef float f32x2 __attribute__((ext_vector_type(2)));
typedef unsigned u32x4 __attribute__((ext_vector_type(4)));
typedef unsigned u32x2 __attribute__((ext_vector_type(2)));

#ifndef MK_MULTI
#define MK_MULTI 0
#endif

constexpr int T_ = 32768, S_ = 2048, D_ = 1024;
constexpr int PW = 5376;
constexpr int PTOT = 8448;
constexpr int LDS_BYTES = 163840;
constexpr size_t MiB = 1024ull * 1024ull;
constexpr size_t W_OFF = 0;
constexpr size_t WT_IN = 0, WT_GLU = WT_IN + (size_t)8448 * 1024, WT_BR = WT_GLU + (size_t)512 * 512, WT_OUT = WT_BR + (size_t)1024 * 2048,
                 WT_FF1 = WT_OUT + (size_t)1024 * 1024, WT_FF2 = WT_FF1 + (size_t)4096 * 1024;
constexpr size_t XBF_OFF = 80 * MiB;
constexpr size_t P_OFF = 144 * MiB;
constexpr size_t GT_OFF = P_OFF, MG_OFF = P_OFF + 192 * MiB, H_OFF = P_OFF, PRE_OFF = P_OFF + 256 * MiB;
constexpr size_t CPRE_OFF = 480 * MiB;
constexpr size_t WS_END = 512 * MiB;
constexpr size_t BAR_OFF = 40 * MiB - 65536;
constexpr float DN_ALPHA = 1.41421356237f;

struct Params {
    const float* x; const float* w_in; const float* b_gate; const float* a_shift; const float* a_w0; const float* a_w2;
    const float* a_a0; const float* a_a2; const float* a_g2; const float* a_kk; const float* a_ka; const float* a_rk;
    const float* a_lnx_g; const float* a_lnx_b; const float* c_lam_re; const float* c_lam_im; const float* c_log_dt;
    const float* c_b_re; const float* c_b_im; const float* c_c_re; const float* c_c_im; const float* c_d;
    const float* c_w_glu; const float* c_b_glu; const float* w_branch; const float* w_out; const float* ln1_g; const float* ln1_b;
    const float* w_ff1; const float* w_ff2; const float* ln2_g; const float* ln2_b;
    float* out; unsigned char* ws;
};

__device__ __forceinline__ float bf2f(bf16_t b) { return __uint_as_float(((unsigned)b) << 16); }
__device__ __forceinline__ float bflo(unsigned w) { return __uint_as_float(w << 16); }
__device__ __forceinline__ float bfhi(unsigned w) { return __uint_as_float(w & 0xffff0000u); }
typedef __bf16 bf16x2_t __attribute__((ext_vector_type(2)));
__device__ __forceinline__ unsigned pk2(float lo, float hi) { const f32x2 v = {lo, hi}; const bf16x2_t b = __builtin_convertvector(v, bf16x2_t); return __builtin_bit_cast(unsigned, b); }
__device__ __forceinline__ bf16_t f2bf(float f) { const __bf16 b = (__bf16)f; return __builtin_bit_cast(unsigned short, b); }
__device__ __forceinline__ float sigmoidf_(float x) { return __builtin_amdgcn_rcpf(1.0f + __builtin_amdgcn_exp2f(-1.4426950408889634f * x)); }
__device__ __forceinline__ float tanhf_(float x) { return 1.0f - 2.0f * __builtin_amdgcn_rcpf(1.0f + __builtin_amdgcn_exp2f(2.8853900817779268f * x)); }
template <int CTRL> __device__ __forceinline__ float dppf(float x) { return __int_as_float(__builtin_amdgcn_update_dpp(0, __float_as_int(x), CTRL, 0xF, 0xF, false)); }
__device__ __forceinline__ float sum8(float x) { x += dppf<0xB1>(x); x += dppf<0x4E>(x); x += dppf<0x141>(x); return x; }
__device__ __forceinline__ float sum16(float x) { x += dppf<0xB1>(x); x += dppf<0x4E>(x); x += dppf<0x141>(x); x += dppf<0x140>(x); return x; }
__device__ __forceinline__ float wave_sum(float v) {
#pragma unroll
    for (int o = 1; o < 64; o <<= 1) v += __shfl_xor(v, o);
    return v;
}
__device__ __forceinline__ void wave_lds_fence() { asm volatile("s_waitcnt lgkmcnt(0)" ::: "memory"); __builtin_amdgcn_wave_barrier(); asm volatile("" ::: "memory"); }
#define MFMA16(a, b, c) __builtin_amdgcn_mfma_f32_16x16x32_bf16((a), (b), (c), 0, 0, 0)


#define XB_TMO      128
#define XB_XCNT(j)  (256  + 64 * (j))
#define XB_XSUB(j)  (1280 + 64 * (j))
#define XB_XGEN(j)  (2304 + 64 * (j))
#define XB_TOP      3328
#define XB_TOPGEN   3392
#define XCD_BAR_WORDS 3456
#define XB_SPIN_CAP (1u << 22)
__device__ __forceinline__ unsigned xb_ld(unsigned* p)              { return __hip_atomic_load(p, __ATOMIC_RELAXED, __HIP_MEMORY_SCOPE_AGENT); }
__device__ __forceinline__ unsigned xb_add(unsigned* p, unsigned v) { return __hip_atomic_fetch_add(p, v, __ATOMIC_RELAXED, __HIP_MEMORY_SCOPE_AGENT); }
__device__ __forceinline__ unsigned xb_xcc_id() { return (unsigned)__builtin_amdgcn_s_getreg((3 << 11) | 20) & 0xFu; }
#define XB_SPIN(cond, bar) do { unsigned _sp = 0; while (cond) { __builtin_amdgcn_s_sleep(1); \
    if ((++_sp & 255u) == 0u) { if (xb_ld(&(bar)[XB_TMO])) break; if (_sp > XB_SPIN_CAP) { atomicAdd(&(bar)[XB_TMO], 1u); break; } } } } while (0)
struct XcdBarrier { unsigned* bar; unsigned x; volatile LAS unsigned* st; };
__device__ __forceinline__ XcdBarrier xcd_barrier_post(unsigned* bar, volatile LAS unsigned* st) {
    XcdBarrier b; b.bar = bar; b.x = xb_xcc_id(); b.st = st;
    if (threadIdx.x == 0) (void)xb_add(&bar[XB_XCNT(b.x)], 1u);
    return b;
}
__device__ __forceinline__ void xcd_barrier_complete(unsigned* bar, unsigned x, unsigned& nloc, unsigned& nx) {
    const unsigned G = gridDim.x * gridDim.y * gridDim.z;
    unsigned sum, cnt, mine, sp = 0u;
    for (;;) {
        sum = 0u; cnt = 0u; mine = 0u;
#pragma unroll
        for (unsigned j = 0; j < 16; ++j) { const unsigned c = xb_ld(&bar[XB_XCNT(j)]); sum += c; cnt += (c > 0u) ? 1u : 0u; mine = (j == x) ? c : mine; }
        if (sum == G) break;
        __builtin_amdgcn_s_sleep(1);
        if ((++sp & 255u) == 0u) { if (xb_ld(&bar[XB_TMO])) break; if (sp > XB_SPIN_CAP) { atomicAdd(&bar[XB_TMO], 1u); break; } }
    }
    nloc = mine > 0u ? mine : 1u; nx = cnt > 0u ? cnt : 1u;
}
__device__ __forceinline__ void xcd_barrier(const XcdBarrier& b) {
    asm volatile("s_waitcnt vmcnt(0)" ::: "memory");
    __syncthreads();
    if (threadIdx.x == 0) {
        unsigned* bar = b.bar;
        __builtin_amdgcn_s_waitcnt(0);
        unsigned nloc = b.st[0], nx = b.st[1];
        if (nloc == 0u) { xcd_barrier_complete(bar, b.x, nloc, nx); b.st[0] = nloc; b.st[1] = nx; }
        const unsigned old = xb_add(&bar[XB_XSUB(b.x)], 1u);
        const unsigned gen = old / nloc;
        if (old + 1u == (gen + 1u) * nloc) {
            __builtin_amdgcn_fence(__ATOMIC_RELEASE, "agent");
            asm volatile("s_waitcnt vmcnt(0)" ::: "memory");
            const unsigned og = xb_add(&bar[XB_TOP], 1u);
            const unsigned tg = og / nx;
            if (og + 1u == (tg + 1u) * nx) xb_add(&bar[XB_TOPGEN], 1u);
            else XB_SPIN(xb_ld(&bar[XB_TOPGEN]) == tg, bar);
            __builtin_amdgcn_fence(__ATOMIC_ACQUIRE, "agent");
            xb_add(&bar[XB_XGEN(b.x)], 1u);
            asm volatile("s_waitcnt vmcnt(0)" ::: "memory");
        } else {
            XB_SPIN(xb_ld(&bar[XB_XGEN(b.x)]) == gen, bar);
            __builtin_amdgcn_fence(__ATOMIC_ACQUIRE, "agent");
            asm volatile("s_waitcnt vmcnt(0)" ::: "memory");
        }
    }
    __syncthreads();
}

namespace pg8 {
#ifndef MK_SP2
#define MK_SP2 true
#endif
#ifndef MK_ALIGN
#define MK_ALIGN true
#endif
constexpr bool GEMM_SP2 = MK_SP2, GEMM_ALIGN = MK_ALIGN;
constexpr int BM = 256, BK = 64, HALF = 128, HTB = HALF * BK * 2, STAGE_BYTES = 8 * HTB, NXCD = 8, WGM = 8;
__device__ __forceinline__ int lds_byte(int r, int c) { const int st = (r >> 4) * 2 + (c >> 5), rr = r & 15, cc = c & 31, ob = rr * 64 + cc * 2; return st * 1024 + (ob ^ (((ob >> 9) & 1) << 5)); }
__device__ __forceinline__ void stage_rc(int b, int& R, int& C) { const int st = b / 1024, sb = b % 1024, swz = sb ^ (((sb >> 9) & 1) << 5); R = (st >> 1) * 16 + swz / 64; C = (st & 1) * 32 + (swz % 64) / 2; }
__device__ __forceinline__ int perm32(int rho) { const int n = rho >> 4, i = rho & 15; return 8 * (i >> 2) + 4 * n + (i & 3); }
struct Unit { int pm, pn; };
struct Gemm { const bf16_t* A; const bf16_t* Bt; int M, N, K, lda, ldb; };
struct StaticOrder {
    int nM, nN, nwg, G, c;
    __device__ void init(int M, int N, int G_, int c_) { nM = M / BM; nN = N / BM; nwg = nM * nN; G = G_; c = c_; }
    __device__ bool next(int i, Unit& u) const {
        const long L = (long)i * G + c; if (L >= nwg) return false;
        int wgid = (int)L; { const int q = nwg / NXCD, r = nwg % NXCD, xcd = wgid % NXCD, off = wgid / NXCD; wgid = (xcd < r ? xcd * (q + 1) : r * (q + 1) + (xcd - r) * q) + off; }
        const int nig = WGM * nN, gid = wgid / nig, fm = gid * WGM, gsz = (nM - fm) < WGM ? (nM - fm) : WGM;
        u.pm = fm + ((wgid % nig) % gsz); u.pn = (wgid % nig) / gsz; return true;
    }
};
template <class Epi>
__device__ __forceinline__ void gemm_phase(LAS unsigned char* lds, const Gemm g, const StaticOrder& S, const Epi& E, const int tid) {
    const int wid = __builtin_amdgcn_readfirstlane(tid >> 6), lane = tid & 63, wr = wid >> 2, wc = wid & 3, fr = lane & 15, fq = lane >> 4;
    const int K = g.K, nt = K / BK;
    unsigned voffA[2], voffB[2];
#pragma unroll
    for (int i = 0; i < 2; ++i) { int R, C; stage_rc(tid * 16 + i * 8192, R, C); const int Rb = Epi::PERM ? ((R & ~31) + perm32(R & 31)) : R;
        voffA[i] = (unsigned)(R * g.lda + C) * 2u; voffB[i] = (unsigned)(Rb * g.ldb + C) * 2u; }
    const size_t kstep = (size_t)(BK * 2);
    const size_t hA = (size_t)HALF * g.lda * 2, hB = (size_t)HALF * g.ldb * 2;
    const size_t tA = 2 * hA, tB = 2 * hB;
    const unsigned ldsw = (unsigned)wid * 1024u;
    const int aoff = lds_byte(wr * 64 + fr, fq * 8), boff = lds_byte(wc * 32 + fr, fq * 8);
#define PG8_SA(b, h) (((b) * 2 + (h)) * HTB)
#define PG8_SB(b, h) ((4 + (b) * 2 + (h)) * HTB)
#define PG8_STAGE(bufoff, gbase, voff) do { _Pragma("unroll") for (int _i = 0; _i < 2; ++_i) \
        __builtin_amdgcn_global_load_lds((const unsigned*)((const char*)(gbase) + (voff)[_i]), (LAS unsigned*)(lds + (bufoff) + ldsw + _i * 8192), 16, 0, 0); } while (0)
#define PG8_LDA(dst, b, h) do { _Pragma("unroll") for (int m = 0; m < 4; ++m) _Pragma("unroll") for (int k = 0; k < 2; ++k) dst[m][k] = *(const LAS bf16x8*)(lds + PG8_SA(b, h) + aoff + m * 2048 + k * 1024); } while (0)
#define PG8_LDB(dst, b, h) do { _Pragma("unroll") for (int n = 0; n < 2; ++n) _Pragma("unroll") for (int k = 0; k < 2; ++k) dst[n][k] = *(const LAS bf16x8*)(lds + PG8_SB(b, h) + boff + n * 2048 + k * 1024); } while (0)
#define PG8_MMA(ai, bj, At, Bt) do { __builtin_amdgcn_s_setprio(1); _Pragma("unroll") for (int m = 0; m < 4; ++m) _Pragma("unroll") for (int n = 0; n < 2; ++n) _Pragma("unroll") for (int k = 0; k < 2; ++k) \
        acc[ai][bj][m][n] = __builtin_amdgcn_mfma_f32_16x16x32_bf16(Bt[n][k], At[m][k], acc[ai][bj][m][n], 0, 0, 0); __builtin_amdgcn_s_setprio(0); } while (0)
#define PG8_WAIT_V(n) asm volatile("s_waitcnt vmcnt(" #n ")" ::: "memory")
#define PG8_WAIT_L(n) asm volatile("s_waitcnt lgkmcnt(" #n ")" ::: "memory")
#define PG8_BAR __builtin_amdgcn_s_barrier()
#define PG8_SCHED __builtin_amdgcn_sched_barrier(0)
    Unit cur, nxt; int ui = 0;
    if (!S.next(0, cur)) return;
    f32x4 acc[2][2][4][2];
#pragma unroll
    for (int a = 0; a < 2; ++a)
#pragma unroll
        for (int b = 0; b < 2; ++b)
#pragma unroll
            for (int m = 0; m < 4; ++m)
#pragma unroll
                for (int n = 0; n < 2; ++n) acc[a][b][m][n] = (f32x4){0.f, 0.f, 0.f, 0.f};
    bf16x8 At[4][2], B0[2][2], B1[2][2];
    const char* cA = (const char*)g.A + (size_t)cur.pm * tA; const char* cB = (const char*)g.Bt + (size_t)cur.pn * tB;
    if constexpr (GEMM_SP2) {
        PG8_STAGE(PG8_SB(0, 0), cB, voffB); PG8_STAGE(PG8_SB(0, 1), cB + hB, voffB); PG8_STAGE(PG8_SA(0, 0), cA, voffA); PG8_STAGE(PG8_SA(0, 1), cA + hA, voffA);
        if (wr == 1) PG8_BAR;
        PG8_WAIT_V(2); PG8_BAR;
        PG8_STAGE(PG8_SB(1, 0), cB + kstep, voffB); PG8_STAGE(PG8_SA(1, 0), cA + kstep, voffA); PG8_STAGE(PG8_SB(1, 1), cB + hB + kstep, voffB);
        PG8_WAIT_V(6); PG8_BAR;
    } else {
    PG8_STAGE(PG8_SB(0, 0), cB, voffB); PG8_STAGE(PG8_SA(0, 0), cA, voffA); PG8_STAGE(PG8_SB(0, 1), cB + hB, voffB); PG8_STAGE(PG8_SA(0, 1), cA + hA, voffA);
    if (wr == 1) PG8_BAR;
    PG8_WAIT_V(4); PG8_BAR;
    PG8_STAGE(PG8_SB(1, 0), cB + kstep, voffB); PG8_STAGE(PG8_SA(1, 0), cA + kstep, voffA); PG8_STAGE(PG8_SB(1, 1), cB + hB + kstep, voffB);
    PG8_WAIT_V(6); PG8_BAR;
    }
    for (;;) {
        const bool has_next = S.next(ui + 1, nxt);
        const char* nA = has_next ? (const char*)g.A + (size_t)nxt.pm * tA : cA; const char* nB = has_next ? (const char*)g.Bt + (size_t)nxt.pn * tB : cB;
        for (int t = 0; t < nt; t += 2) {
            const bool last = (t == nt - 2);
            const char* a1 = cA + (size_t)(t + 1) * kstep;
            const char* a2 = last ? nA : cA + (size_t)(t + 2) * kstep; const char* b2 = last ? nB : cB + (size_t)(t + 2) * kstep;
            const char* a3 = a2 + kstep; const char* b3 = b2 + kstep;
            if constexpr (Epi::KHOOK) { if (t == 8 || t == 24) E.khook(acc, cur, t, wr, wc, fr, fq); }
            if constexpr (GEMM_SP2) {
            PG8_LDB(B0, 0, 0); PG8_LDB(B1, 0, 1); PG8_SCHED; PG8_LDA(At, 0, 0); PG8_STAGE(PG8_SA(1, 1), a1 + hA, voffA);
            PG8_WAIT_V(8); PG8_WAIT_L(0); PG8_BAR; PG8_MMA(0, 0, At, B0); PG8_MMA(0, 1, At, B1); PG8_BAR; PG8_SCHED;
            PG8_LDA(At, 0, 1); PG8_STAGE(PG8_SB(0, 0), b2, voffB); PG8_STAGE(PG8_SB(0, 1), b2 + hB, voffB); PG8_STAGE(PG8_SA(0, 0), a2, voffA);
            PG8_WAIT_V(8); PG8_WAIT_L(0); PG8_BAR; PG8_MMA(1, 0, At, B0); PG8_MMA(1, 1, At, B1); PG8_BAR; PG8_SCHED;
            PG8_LDB(B0, 1, 0); PG8_LDB(B1, 1, 1); PG8_SCHED; PG8_LDA(At, 1, 0); PG8_STAGE(PG8_SA(0, 1), a2 + hA, voffA);
            PG8_WAIT_V(8); PG8_WAIT_L(0); PG8_BAR; PG8_MMA(0, 0, At, B0); PG8_MMA(0, 1, At, B1); PG8_BAR; PG8_SCHED;
            PG8_LDA(At, 1, 1); PG8_STAGE(PG8_SB(1, 0), b3, voffB); PG8_STAGE(PG8_SB(1, 1), b3 + hB, voffB); PG8_STAGE(PG8_SA(1, 0), a3, voffA);
            PG8_WAIT_V(8); PG8_WAIT_L(0); PG8_BAR; PG8_MMA(1, 0, At, B0); PG8_MMA(1, 1, At, B1); PG8_BAR; PG8_SCHED;
            } else {
            PG8_LDB(B0, 0, 0); PG8_SCHED; PG8_LDA(At, 0, 0); PG8_STAGE(PG8_SA(1, 1), a1 + hA, voffA);
            PG8_WAIT_L(8); PG8_BAR; PG8_WAIT_L(0); PG8_MMA(0, 0, At, B0); PG8_BAR; PG8_SCHED;
            PG8_LDB(B1, 0, 1); PG8_STAGE(PG8_SB(0, 0), b2, voffB);
            PG8_BAR; PG8_WAIT_L(0); PG8_MMA(0, 1, At, B1); PG8_BAR;
            PG8_LDA(At, 0, 1); PG8_STAGE(PG8_SA(0, 0), a2, voffA);
            PG8_BAR; PG8_WAIT_L(0); PG8_MMA(1, 0, At, B0); PG8_BAR; PG8_SCHED;
            PG8_STAGE(PG8_SB(0, 1), b2 + hB, voffB);
            PG8_WAIT_V(6); PG8_BAR; PG8_MMA(1, 1, At, B1); PG8_BAR;
            PG8_LDB(B0, 1, 0); PG8_SCHED; PG8_LDA(At, 1, 0); PG8_STAGE(PG8_SA(0, 1), a2 + hA, voffA);
            PG8_WAIT_L(8); PG8_BAR; PG8_WAIT_L(0); PG8_MMA(0, 0, At, B0); PG8_BAR; PG8_SCHED;
            PG8_LDB(B1, 1, 1); PG8_STAGE(PG8_SB(1, 0), b3, voffB);
            PG8_BAR; PG8_WAIT_L(0); PG8_MMA(0, 1, At, B1); PG8_BAR;
            PG8_LDA(At, 1, 1); PG8_STAGE(PG8_SA(1, 0), a3, voffA);
            PG8_BAR; PG8_WAIT_L(0); PG8_MMA(1, 0, At, B0); PG8_BAR; PG8_SCHED;
            PG8_STAGE(PG8_SB(1, 1), b3 + hB, voffB);
            PG8_WAIT_V(6); PG8_BAR; PG8_MMA(1, 1, At, B1); PG8_BAR;
            }
        }
        if constexpr (GEMM_ALIGN) { if (wr == 0) PG8_BAR; }
        E(acc, cur, wr, wc, fr, fq);
        if (!has_next) break;
#pragma unroll
        for (int a = 0; a < 2; ++a)
#pragma unroll
            for (int b = 0; b < 2; ++b)
#pragma unroll
                for (int m = 0; m < 4; ++m)
#pragma unroll
                    for (int n = 0; n < 2; ++n) acc[a][b][m][n] = (f32x4){0.f, 0.f, 0.f, 0.f};
        cur = nxt; cA = nA; cB = nB; ++ui;
        if constexpr (GEMM_ALIGN) { if (wr == 1) PG8_BAR; }
    }
    PG8_WAIT_V(0);
    if constexpr (!GEMM_ALIGN) { if (wr == 0) PG8_BAR; }
    PG8_BAR;
#undef PG8_SA
#undef PG8_SB
#undef PG8_STAGE
#undef PG8_LDA
#undef PG8_LDB
#undef PG8_MMA
#undef PG8_WAIT_V
#undef PG8_WAIT_L
#undef PG8_BAR
#undef PG8_SCHED
}
}
using pg8::Unit;

#define EPI_FOR_ROWS  _Pragma("unroll") for (int ai = 0; ai < 2; ++ai) _Pragma("unroll") for (int m = 0; m < 4; ++m)
#define EPI_FOR_COLS  _Pragma("unroll") for (int bj = 0; bj < 2; ++bj) _Pragma("unroll") for (int n = 0; n < 2; ++n)
#define EPI_FOR_BJ    _Pragma("unroll") for (int bj = 0; bj < 2; ++bj)
#define EPI_ROW (u.pm * 256 + ai * 128 + wr * 64 + m * 16 + fr)
#define EPI_COL (u.pn * 256 + bj * 128 + wc * 32 + n * 16 + 4 * fq)
#define EPI_COL8 (u.pn * 256 + bj * 128 + wc * 32 + 8 * fq)
typedef f32x4 AccT[2][2][4][2];

__device__ __forceinline__ void st_bf4(bf16_t* p, f32x4 v) { u32x2 w; w.x = pk2(v[0], v[1]); w.y = pk2(v[2], v[3]); *(u32x2*)p = w; }
__device__ __forceinline__ void st_bf8(bf16_t* p, f32x4 v0, f32x4 v1) { u32x4 w; w.x = pk2(v0[0], v0[1]); w.y = pk2(v0[2], v0[3]); w.z = pk2(v1[0], v1[1]); w.w = pk2(v1[2], v1[3]); *(u32x4*)p = w; }
__device__ __forceinline__ f32x4 ld_bf4(const bf16_t* p) { const u32x2 w = *(const u32x2*)p; return (f32x4){bflo(w.x), bfhi(w.x), bflo(w.y), bfhi(w.y)}; }
__device__ __forceinline__ f32x4 bf4lo(u32x4 w) { return (f32x4){bflo(w.x), bfhi(w.x), bflo(w.y), bfhi(w.y)}; }
__device__ __forceinline__ f32x4 bf4hi(u32x4 w) { return (f32x4){bflo(w.z), bfhi(w.z), bflo(w.w), bfhi(w.w)}; }

struct EpiStore {
    static constexpr bool KHOOK = false, PERM = true;
    bf16_t* O; int ldc;
    __device__ __forceinline__ void operator()(const AccT& acc, const Unit& u, int wr, int wc, int fr, int fq) const {
        EPI_FOR_ROWS { bf16_t* rp = O + (size_t)EPI_ROW * ldc; EPI_FOR_BJ st_bf8(rp + EPI_COL8, acc[ai][bj][m][0], acc[ai][bj][m][1]); }
    }
    __device__ __forceinline__ void khook(AccT&, const Unit&, int, int, int, int, int) const {}
};
struct EpiSqRelu {
    static constexpr bool KHOOK = false, PERM = true;
    bf16_t* O; int ldc;
    __device__ __forceinline__ void operator()(const AccT& acc, const Unit& u, int wr, int wc, int fr, int fq) const {
        EPI_FOR_ROWS { bf16_t* rp = O + (size_t)EPI_ROW * ldc; EPI_FOR_BJ { f32x4 v0 = acc[ai][bj][m][0], v1 = acc[ai][bj][m][1];
#pragma unroll
            for (int j = 0; j < 4; ++j) { const float r0 = fmaxf(v0[j], 0.f), r1 = fmaxf(v1[j], 0.f); v0[j] = r0 * r0; v1[j] = r1 * r1; }
            st_bf8(rp + EPI_COL8, v0, v1); } }
    }
    __device__ __forceinline__ void khook(AccT&, const Unit&, int, int, int, int, int) const {}
};
struct EpiSigmoid {
    static constexpr bool KHOOK = false, PERM = true;
    bf16_t* O; int ldc; const float* bias;
    __device__ __forceinline__ void operator()(const AccT& acc, const Unit& u, int wr, int wc, int fr, int fq) const {
        f32x4 bv[2][2];
        EPI_FOR_BJ { const int c = EPI_COL8; bv[bj][0] = *(const f32x4*)(bias + c); bv[bj][1] = *(const f32x4*)(bias + c + 4); }
        EPI_FOR_ROWS { bf16_t* rp = O + (size_t)EPI_ROW * ldc; EPI_FOR_BJ { f32x4 v0 = acc[ai][bj][m][0] + bv[bj][0], v1 = acc[ai][bj][m][1] + bv[bj][1];
#pragma unroll
            for (int j = 0; j < 4; ++j) { v0[j] = sigmoidf_(v0[j]); v1[j] = sigmoidf_(v1[j]); }
            st_bf8(rp + EPI_COL8, v0, v1); } }
    }
    __device__ __forceinline__ void khook(AccT&, const Unit&, int, int, int, int, int) const {}
};
struct EpiGlu {
    static constexpr bool KHOOK = false, PERM = true;
    bf16_t* O; int ldc; int ocol0; const bf16_t* Yin; int ldy; const float* bias;
    __device__ __forceinline__ void operator()(const AccT& acc, const Unit& u, int wr, int wc, int fr, int fq) const {
#pragma unroll
        for (int ai = 0; ai < 2; ++ai) {
            u32x4 yq[4][2];
#pragma unroll
            for (int m = 0; m < 4; ++m) { const size_t row = (size_t)EPI_ROW; EPI_FOR_BJ yq[m][bj] = *(const u32x4*)(Yin + row * ldy + EPI_COL8); }
            __builtin_amdgcn_sched_barrier(0);
#pragma unroll
            for (int m = 0; m < 4; ++m) { const size_t row = (size_t)EPI_ROW; EPI_FOR_BJ { const int c = EPI_COL8; const u32x4 w = yq[m][bj]; const f32x4 y0 = bf4lo(w), y1 = bf4hi(w);
                f32x4 v0 = acc[ai][bj][m][0] + *(const f32x4*)(bias + c), v1 = acc[ai][bj][m][1] + *(const f32x4*)(bias + c + 4);
#pragma unroll
                for (int j = 0; j < 4; ++j) { v0[j] = y0[j] * sigmoidf_(v0[j]); v1[j] = y1[j] * sigmoidf_(v1[j]); }
                st_bf8(O + row * ldc + ocol0 + c, v0, v1); } }
            __builtin_amdgcn_sched_barrier(0);
        }
    }
    __device__ __forceinline__ void khook(AccT&, const Unit&, int, int, int, int, int) const {}
};
struct EpiMerge {
    static constexpr bool KHOOK = true, PERM = true;
    bf16_t* O; const bf16_t* G;
    __device__ __forceinline__ void khook(AccT& acc, const Unit& u, int t, int wr, int wc, int fr, int fq) const {
        unsigned goff = (unsigned)((u.pm * 256 + wr * 64 + fr) * 3072 + u.pn * 256 + wc * 32 + 8 * fq + ((t == 8) ? 0 : 1024)) * 2u;
        asm volatile("" : "+v"(goff));
        const char* gb = (const char*)G;
#pragma unroll
        for (int ai = 0; ai < 2; ++ai) {
            u32x4 q0[4][2], q1[4][2];
#pragma unroll
            for (int m = 0; m < 4; ++m) EPI_FOR_BJ { const unsigned o = goff + (unsigned)(((ai * 128 + m * 16) * 3072 + bj * 128) * 2);
                q0[m][bj] = *(const u32x4*)(gb + o); q1[m][bj] = *(const u32x4*)(gb + o + 2048); }
            __builtin_amdgcn_sched_barrier(0);
#pragma unroll
            for (int m = 0; m < 4; ++m) EPI_FOR_BJ { const u32x4 a = q0[m][bj], b = q1[m][bj];
                const f32x4 g00 = bf4lo(a), g01 = bf4hi(a), g10 = bf4lo(b), g11 = bf4hi(b);
#pragma unroll
                for (int j = 0; j < 4; ++j) { acc[ai][bj][m][0][j] *= g00[j] * __builtin_amdgcn_rcpf(g10[j]); acc[ai][bj][m][1][j] *= g01[j] * __builtin_amdgcn_rcpf(g11[j]); } }
            __builtin_amdgcn_sched_barrier(0);
        }
    }
    __device__ __forceinline__ void operator()(const AccT& acc, const Unit& u, int wr, int wc, int fr, int fq) const {
        u32x4 gq[2][4][2];
        EPI_FOR_ROWS { const size_t row = (size_t)EPI_ROW; EPI_FOR_BJ gq[ai][m][bj] = *(const u32x4*)(G + row * 3072 + 2048 + EPI_COL8); }
        __builtin_amdgcn_sched_barrier(0);
        EPI_FOR_ROWS { const size_t row = (size_t)EPI_ROW; EPI_FOR_BJ { const u32x4 w = gq[ai][m][bj];
            st_bf8(O + row * 1024 + EPI_COL8, acc[ai][bj][m][0] * bf4lo(w), acc[ai][bj][m][1] * bf4hi(w)); } }
    }
};
struct EpiResid {
    static constexpr bool KHOOK = false, PERM = true;
    bf16_t* C; const bf16_t* X;
    __device__ __forceinline__ void operator()(const AccT& acc, const Unit& u, int wr, int wc, int fr, int fq) const {
        u32x4 xq[2][4][2];
        EPI_FOR_ROWS { const size_t row = (size_t)EPI_ROW; EPI_FOR_BJ xq[ai][m][bj] = *(const u32x4*)(X + row * 1024 + EPI_COL8); }
        __builtin_amdgcn_sched_barrier(0);
        EPI_FOR_ROWS { const size_t row = (size_t)EPI_ROW; EPI_FOR_BJ { const u32x4 w = xq[ai][m][bj];
            st_bf8(C + row * 1024 + EPI_COL8, bf4lo(w) * DN_ALPHA + acc[ai][bj][m][0], bf4hi(w) * DN_ALPHA + acc[ai][bj][m][1]); } }
    }
    __device__ __forceinline__ void khook(AccT&, const Unit&, int, int, int, int, int) const {}
};

template <class Epi>
__device__ __forceinline__ void run_gemm(const int tid, const int bid, const int gsz, unsigned char* smem, const bf16_t* A, int lda, const bf16_t* Bt, int ldb, int N, int K, const Epi& E) {
    pg8::Gemm g; g.A = A; g.Bt = Bt; g.M = T_; g.N = N; g.K = K; g.lda = lda; g.ldb = ldb;
    pg8::StaticOrder S; S.init(T_, N, gsz, bid);
    pg8::gemm_phase<Epi>((LAS unsigned char*)smem, g, S, E, tid);
}

__device__ __forceinline__ void transpose_cvt(const int tid, const int bid, const int gsz, const float* __restrict__ src, int K, int N, bf16_t* __restrict__ dst, float* tile) {
    const int tn = N / 64, ntile = (K / 64) * tn;
    for (int t = bid; t < ntile; t += gsz) {
        const int k0 = (t / tn) * 64, n0 = (t % tn) * 64;
#pragma unroll
        for (int r = 0; r < 2; ++r) { const int i = (tid >> 4) + 32 * r, j = (tid & 15) * 4;
            const f32x4 v = *(const f32x4*)(src + (size_t)(k0 + i) * N + n0 + j);
            tile[i * 65 + j] = v[0]; tile[i * 65 + j + 1] = v[1]; tile[i * 65 + j + 2] = v[2]; tile[i * 65 + j + 3] = v[3]; }
        __syncthreads();
        const int jn = tid >> 3, i8 = (tid & 7) * 8;
        u32x4 w;
        w.x = pk2(tile[(i8 + 0) * 65 + jn], tile[(i8 + 1) * 65 + jn]); w.y = pk2(tile[(i8 + 2) * 65 + jn], tile[(i8 + 3) * 65 + jn]);
        w.z = pk2(tile[(i8 + 4) * 65 + jn], tile[(i8 + 5) * 65 + jn]); w.w = pk2(tile[(i8 + 6) * 65 + jn], tile[(i8 + 7) * 65 + jn]);
        *(u32x4*)(dst + (size_t)(n0 + jn) * K + k0 + i8) = w;
        __syncthreads();
    }
}
__device__ __forceinline__ void phase_convert(const int tid, const int bid, const int gsz, const Params& p, int l, unsigned char* smem) {
    float* tile = (float*)smem;
    bf16_t* W = (bf16_t*)(p.ws + W_OFF + (size_t)l * 40 * MiB);
    transpose_cvt(tid, bid, gsz, p.w_in + (size_t)l * 1024 * PTOT, 1024, PTOT, W + WT_IN, tile);
    transpose_cvt(tid, bid, gsz, p.c_w_glu + (size_t)l * 512 * 512, 512, 512, W + WT_GLU, tile);
    transpose_cvt(tid, bid, gsz, p.w_branch + (size_t)l * 2048 * 1024, 2048, 1024, W + WT_BR, tile);
    transpose_cvt(tid, bid, gsz, p.w_out + (size_t)l * 1024 * 1024, 1024, 1024, W + WT_OUT, tile);
    transpose_cvt(tid, bid, gsz, p.w_ff1 + (size_t)l * 1024 * 4096, 1024, 4096, W + WT_FF1, tile);
    transpose_cvt(tid, bid, gsz, p.w_ff2 + (size_t)l * 4096 * 1024, 4096, 1024, W + WT_FF2, tile);
    if (l == 0) {
        bf16_t* X = (bf16_t*)(p.ws + XBF_OFF);
        const size_t n4 = (size_t)T_ * D_ / 4;
        for (size_t i = (size_t)bid * 512 + tid; i < n4; i += (size_t)gsz * 512) {
            const f32x4 v = *(const f32x4*)(p.x + i * 4); st_bf4(X + i * 4, v); }
    }
}

__device__ __forceinline__ void phase_ln(const int tid, const int bid, const int gsz, const bf16_t* src, const float* gam, const float* bet, bf16_t* xbf, float* fout) {
    const int lane = tid & 63, wid = tid >> 6;
    f32x4 gv[4], bv[4];
#pragma unroll
    for (int j = 0; j < 4; ++j) { gv[j] = *(const f32x4*)(gam + lane * 4 + 256 * j); bv[j] = *(const f32x4*)(bet + lane * 4 + 256 * j); }
    for (int row = bid * 8 + wid; row < T_; row += gsz * 8) {
        const bf16_t* rp = src + (size_t)row * D_;
        f32x4 v[4]; float s = 0.f;
#pragma unroll
        for (int j = 0; j < 4; ++j) { v[j] = ld_bf4(rp + lane * 4 + 256 * j); s += (v[j][0] + v[j][1]) + (v[j][2] + v[j][3]); }
        const float mean = wave_sum(s) * (1.f / D_); float s2 = 0.f;
#pragma unroll
        for (int j = 0; j < 4; ++j) { v[j] = v[j] - mean; s2 += (v[j][0] * v[j][0] + v[j][1] * v[j][1]) + (v[j][2] * v[j][2] + v[j][3] * v[j][3]); }
        const float rstd = rsqrtf(wave_sum(s2) * (1.f / D_) + 1e-5f);
#pragma unroll
        for (int j = 0; j < 4; ++j) { const f32x4 o = v[j] * rstd * gv[j] + bv[j];
            st_bf4(xbf + (size_t)row * D_ + lane * 4 + 256 * j, o);
            if (fout) *(f32x4*)(fout + (size_t)row * D_ + lane * 4 + 256 * j) = o; }
    }
}

__device__ __forceinline__ int rwkv_gcol(int vi, int h) { return (vi < 24) ? ((vi >> 3) * 512 + h * 64 + (vi & 7) * 8) : (1536 + (vi - 24) * 8); }
__device__ __forceinline__ void prep_bar(unsigned* cnt, unsigned& gen, int lane) {
    gen += 4u;
    asm volatile("s_waitcnt lgkmcnt(0)" ::: "memory");
    if (lane == 0) __hip_atomic_fetch_add(cnt, 1u, __ATOMIC_RELAXED, __HIP_MEMORY_SCOPE_WORKGROUP);
    while (__hip_atomic_load(cnt, __ATOMIC_RELAXED, __HIP_MEMORY_SCOPE_WORKGROUP) < gen) __builtin_amdgcn_s_sleep(1);
    asm volatile("" ::: "memory");
}
__device__ __forceinline__ void rwkv_item(const int tid, const Params& p, int l, int b, int h, unsigned char* smem) {
    const int lane = tid & 63, wid = tid >> 6, quad = lane >> 4, l15 = lane & 15;
    float* R2 = (float*)smem; float* K2 = R2 + 4096; float* V2 = K2 + 4096; float* W2 = V2 + 4096; float* NA2 = W2 + 4096; float* NB2 = NA2 + 4096;
    float* G2 = NB2 + 4096; float* O2 = G2 + 4096; float* A_ = O2 + 4096; float* RK2 = A_ + 2048;
    bf16_t* ZL = (bf16_t*)(RK2 + 64);
    float* MU = (float*)(ZL + 32 * 264);
    unsigned* SBAR = (unsigned*)(MU + 448);
    const bf16_t* P = (const bf16_t*)(p.ws + P_OFF) + (size_t)b * S_ * PW;
    bf16_t* Y = (bf16_t*)p.out + (size_t)b * S_ * 2048;
    for (int c = tid; c < 448; c += 512) { const int vi = c >> 3; MU[c] = p.a_shift[l * 1792 + rwkv_gcol(vi, h) + (c & 7)]; }
    if (tid == 0) SBAR[0] = 0u;
    __syncthreads();
    if (tid < 256) {
        const int sv = (tid >> 3) & 31, sj = tid & 7;
        f32x2 SA[4], SB[4];
#pragma unroll
        for (int i = 0; i < 4; ++i) { SA[i] = (f32x2){0.f, 0.f}; SB[i] = SA[i]; }
        __syncthreads();
        for (int ch = 0; ch < S_ / 32; ++ch) {
            const int cb = (ch & 1) * 2048;
            const float* Rc = R2 + cb; const float* Kc = K2 + cb; const float* Vc = V2 + cb; const float* Wc = W2 + cb; const float* NAc = NA2 + cb; const float* NBc = NB2 + cb;
            float* Oc = O2 + cb;
            f32x4 cna0, cna1, cw0, cw1, cnb0, cnb1, ckt0, ckt1, cr0, cr1; float cva, cvb;
#define RW_LOAD(tt_) do { const int o_ = (tt_) * 64 + sj * 8; \
            cna0 = *(const f32x4*)(NAc + o_); cna1 = *(const f32x4*)(NAc + o_ + 4); cw0 = *(const f32x4*)(Wc + o_); cw1 = *(const f32x4*)(Wc + o_ + 4); \
            cnb0 = *(const f32x4*)(NBc + o_); cnb1 = *(const f32x4*)(NBc + o_ + 4); ckt0 = *(const f32x4*)(Kc + o_); ckt1 = *(const f32x4*)(Kc + o_ + 4); \
            cr0 = *(const f32x4*)(Rc + o_); cr1 = *(const f32x4*)(Rc + o_ + 4); cva = Vc[(tt_) * 64 + sv]; cvb = Vc[(tt_) * 64 + sv + 32]; } while (0)
            RW_LOAD(0);
#pragma unroll 32
            for (int tt = 0; tt < 32; ++tt) {
                const f32x4 na0 = cna0, na1 = cna1, w0 = cw0, w1 = cw1, nb0 = cnb0, nb1 = cnb1, kt0 = ckt0, kt1 = ckt1, r0 = cr0, r1 = cr1; const float va = cva, vb = cvb;
                { const int tn = (tt + 1) & 31; RW_LOAD(tn); }
                const f32x2 n0 = {na0[0], na0[1]}, n1 = {na0[2], na0[3]}, n2 = {na1[0], na1[1]}, n3 = {na1[2], na1[3]};
                f32x2 pa = SA[0] * n0; pa = SA[1] * n1 + pa; pa = SA[2] * n2 + pa; pa = SA[3] * n3 + pa;
                f32x2 pb = SB[0] * n0; pb = SB[1] * n1 + pb; pb = SB[2] * n2 + pb; pb = SB[3] * n3 + pb;
                float sa = pa[0] + pa[1], sb = pb[0] + pb[1];
                sa = sum8(sa); sb = sum8(sb);
                const f32x2 wv[4] = {{w0[0], w0[1]}, {w0[2], w0[3]}, {w1[0], w1[1]}, {w1[2], w1[3]}};
                const f32x2 nbv[4] = {{nb0[0], nb0[1]}, {nb0[2], nb0[3]}, {nb1[0], nb1[1]}, {nb1[2], nb1[3]}};
                const f32x2 ktv[4] = {{kt0[0], kt0[1]}, {kt0[2], kt0[3]}, {kt1[0], kt1[1]}, {kt1[2], kt1[3]}};
#pragma unroll
                for (int i = 0; i < 4; ++i) { SA[i] = SA[i] * wv[i] + (nbv[i] * sa + ktv[i] * va); SB[i] = SB[i] * wv[i] + (nbv[i] * sb + ktv[i] * vb); }
                const f32x2 q0 = {r0[0], r0[1]}, q1 = {r0[2], r0[3]}, q2 = {r1[0], r1[1]}, q3 = {r1[2], r1[3]};
                f32x2 oa = SA[0] * q0; oa = SA[1] * q1 + oa; oa = SA[2] * q2 + oa; oa = SA[3] * q3 + oa;
                f32x2 ob = SB[0] * q0; ob = SB[1] * q1 + ob; ob = SB[2] * q2 + ob; ob = SB[3] * q3 + ob;
                float xa = oa[0] + oa[1], xb = ob[0] + ob[1];
                xa = sum8(xa); xb = sum8(xb);
                Oc[tt * 64 + sv] = xa; Oc[tt * 64 + sv + 32] = xb;
            }
#undef RW_LOAD
            __syncthreads();
        }
        __syncthreads();
    } else {
        const int st = tid - 256, pw = wid - 4;
        const int ocol = h * 64 + pw * 16 + l15;
        bf16x8 Bw[2], Ba[2], Bg[4];
#pragma unroll
        for (int ks = 0; ks < 2; ++ks)
#pragma unroll
            for (int jj = 0; jj < 8; ++jj) { const int k = ks * 32 + quad * 8 + jj;
                Bw[ks][jj] = (short)f2bf(p.a_w2[((size_t)l * 64 + k) * 512 + ocol]); Ba[ks][jj] = (short)f2bf(p.a_a2[((size_t)l * 64 + k) * 512 + ocol]); }
#pragma unroll
        for (int ks = 0; ks < 4; ++ks)
#pragma unroll
            for (int jj = 0; jj < 8; ++jj) { const int k = ks * 32 + quad * 8 + jj; Bg[ks][jj] = (short)f2bf(p.a_g2[((size_t)l * 128 + k) * 512 + ocol]); }
        const float w0v = p.a_w0[l * 512 + ocol], a0v = p.a_a0[l * 512 + ocol];
        const int ett0 = st >> 4, ecg = st & 15;
        const int hc = l * 512 + h * 64 + ecg * 4;
        const f32x4 kkc = *(const f32x4*)(p.a_kk + hc), kac = *(const f32x4*)(p.a_ka + hc), rkc = *(const f32x4*)(p.a_rk + hc),
                    lng = *(const f32x4*)(p.a_lnx_g + hc), lnb = *(const f32x4*)(p.a_lnx_b + hc);
        int svi, srg;
        if (st < 128) { srg = st >> 5; const int j = st & 31; svi = (j < 24) ? j : (8 + j); }
        else { const int u = st - 128; srg = u / 24; const int j = u - srg * 24; svi = (j < 8) ? (24 + j) : (32 + j); }
        const bool shact = st < 224;
        const float tr_a = (svi < 32) ? 2.0f : 1.0f, tr_b = (svi < 32) ? 2.8853900817779268f : 1.4426950408889634f, tr_c = (svi < 32) ? -1.0f : 0.0f;
        const bf16_t* sptr = P + (size_t)(srg * 8 - 1) * PW + rwkv_gcol(svi, h);
        u32x4 pr[9];
        unsigned gen = 0u;
#define RW_PREFETCH(t0n_) do { if (shact) { _Pragma("unroll") for (int j = 0; j < 9; ++j) { \
        pr[j] = ((t0n_) + srg * 8 - 1 + j >= 0) ? *(const u32x4*)(sptr + (size_t)((t0n_) + j) * PW) : (u32x4){0u, 0u, 0u, 0u}; } } } while (0)
#define RW_SHIFT(nb_) do { if (shact) { float* Rn_ = R2 + (nb_); float* Kn_ = K2 + (nb_); float* Vn_ = V2 + (nb_); const int vi = svi; \
        const f32x4 m0 = *(const f32x4*)(MU + vi * 8), m1 = *(const f32x4*)(MU + vi * 8 + 4); \
        _Pragma("unroll") for (int j = 1; j < 9; ++j) { const int tt = srg * 8 + j - 1; const u32x4 cw = pr[j], pw_ = pr[j - 1]; f32x4 z0, z1; \
            { const f32x4 c0 = {bflo(cw.x), bfhi(cw.x), bflo(cw.y), bfhi(cw.y)}, c1 = {bflo(cw.z), bfhi(cw.z), bflo(cw.w), bfhi(cw.w)}; \
              const f32x4 p0 = {bflo(pw_.x), bfhi(pw_.x), bflo(pw_.y), bfhi(pw_.y)}, p1 = {bflo(pw_.z), bfhi(pw_.z), bflo(pw_.w), bfhi(pw_.w)}; \
              z0 = c0 + m0 * (p0 - c0); z1 = c1 + m1 * (p1 - c1); } \
            if (vi < 24) { float* dst = ((vi < 8) ? Rn_ : (vi < 16) ? Kn_ : Vn_) + tt * 64 + (vi & 7) * 8; *(f32x4*)dst = z0; *(f32x4*)(dst + 4) = z1; } \
            else { if (st >= 128) { _Pragma("unroll") for (int q = 0; q < 4; ++q) { \
                       z0[q] = tr_a * __builtin_amdgcn_rcpf(1.0f + __builtin_amdgcn_exp2f(-tr_b * z0[q])) + tr_c; z1[q] = tr_a * __builtin_amdgcn_rcpf(1.0f + __builtin_amdgcn_exp2f(-tr_b * z1[q])) + tr_c; } } \
                   u32x4 o; o.x = pk2(z0[0], z0[1]); o.y = pk2(z0[2], z0[3]); o.z = pk2(z1[0], z1[1]); o.w = pk2(z1[2], z1[3]); \
                   *(u32x4*)(ZL + tt * 264 + (vi - 24) * 8) = o; } } } } while (0)
#define RW_LORA(nb_) do { _Pragma("unroll") for (int rt = 0; rt < 2; ++rt) { f32x4 cw = {0.f, 0.f, 0.f, 0.f}, ca = cw, cgv = cw; const bf16_t* zrow = ZL + (rt * 16 + l15) * 264 + quad * 8; \
        _Pragma("unroll") for (int ks = 0; ks < 2; ++ks) { const bf16x8 a = *(const bf16x8*)(zrow + ks * 32); cw = MFMA16(a, Bw[ks], cw); } \
        _Pragma("unroll") for (int ks = 0; ks < 2; ++ks) { const bf16x8 a = *(const bf16x8*)(zrow + 64 + ks * 32); ca = MFMA16(a, Ba[ks], ca); } \
        _Pragma("unroll") for (int ks = 0; ks < 4; ++ks) { const bf16x8 a = *(const bf16x8*)(zrow + 128 + ks * 32); cgv = MFMA16(a, Bg[ks], cgv); } \
        _Pragma("unroll") for (int jj = 0; jj < 4; ++jj) { const int tt = rt * 16 + quad * 4 + jj, col = pw * 16 + l15; \
            W2[(nb_) + tt * 64 + col] = __builtin_amdgcn_exp2f(-0.8750387749860377f * sigmoidf_(cw[jj] + w0v)); \
            A_[tt * 64 + col] = sigmoidf_(ca[jj] + a0v); G2[(nb_) + tt * 64 + col] = cgv[jj]; } } } while (0)
#define RW_ELEM(nb_) do { _Pragma("unroll") for (int it = 0; it < 2; ++it) { const int ett = ett0 + 16 * it; const int o = ett * 64 + ecg * 4; float* Kn_ = K2 + (nb_); \
        const f32x4 k4 = *(const f32x4*)(Kn_ + o), a4 = *(const f32x4*)(A_ + o), r4 = *(const f32x4*)(R2 + (nb_) + o); \
        const f32x4 kk = k4 * kkc; float ss = (kk[0] * kk[0] + kk[1] * kk[1]) + (kk[2] * kk[2] + kk[3] * kk[3]); ss = sum16(ss); \
        const float inv = __builtin_amdgcn_rsqf(fmaxf(ss, 1e-24f)); const f32x4 kkn = kk * inv; \
        *(f32x4*)(NA2 + (nb_) + o) = -kkn; *(f32x4*)(NB2 + (nb_) + o) = kkn * a4; \
        const f32x4 kt = k4 * (1.0f + (a4 - 1.0f) * kac); *(f32x4*)(Kn_ + o) = kt; \
        const f32x4 pr_ = r4 * kt * rkc; float rk = (pr_[0] + pr_[1]) + (pr_[2] + pr_[3]); rk = sum16(rk); \
        if (ecg == 0) RK2[((nb_) >> 6) + ett] = rk; } } while (0)
#define RW_OUT(cb_, t0_) do { _Pragma("unroll") for (int it = 0; it < 2; ++it) { const int ett = ett0 + 16 * it; const int o = ett * 64 + ecg * 4; \
        const f32x4 o4 = *(const f32x4*)(O2 + (cb_) + o); float s = (o4[0] + o4[1]) + (o4[2] + o4[3]); s = sum16(s); \
        const float mean = s * (1.f / 64.f); const f32x4 d = o4 - mean; \
        float q = (d[0] * d[0] + d[1] * d[1]) + (d[2] * d[2] + d[3] * d[3]); q = sum16(q); \
        const float rstd = rsqrtf(q * (1.f / 64.f) + 64e-5f); \
        const f32x4 v4 = *(const f32x4*)(V2 + (cb_) + o), g4 = *(const f32x4*)(G2 + (cb_) + o); const float rk = RK2[((cb_) >> 6) + ett]; \
        const f32x4 y = ((d * rstd) * lng + lnb + v4 * rk) * g4; \
        st_bf4(Y + (size_t)((t0_) + ett) * 2048 + h * 64 + ecg * 4, y); } } while (0)
        RW_PREFETCH(0);
        RW_SHIFT(0); RW_PREFETCH(32);
        prep_bar(SBAR, gen, lane);
        RW_LORA(0);
        prep_bar(SBAR, gen, lane);
        RW_ELEM(0);
        __syncthreads();
        for (int ch = 0; ch < S_ / 32; ++ch) {
            const int nb = ((ch + 1) & 1) * 2048;
            if (ch >= 1) RW_OUT(nb, (ch - 1) * 32);
            if (ch + 1 < S_ / 32) {
                prep_bar(SBAR, gen, lane);
                RW_SHIFT(nb);
                if (ch + 2 < S_ / 32) RW_PREFETCH((ch + 2) * 32);
                prep_bar(SBAR, gen, lane);
                RW_LORA(nb);
                prep_bar(SBAR, gen, lane);
                RW_ELEM(nb);
            }
            __syncthreads();
        }
        RW_OUT(2048, (S_ / 32 - 1) * 32);
        __syncthreads();
#undef RW_PREFETCH
#undef RW_SHIFT
#undef RW_LORA
#undef RW_ELEM
#undef RW_OUT
    }
}

__device__ __forceinline__ void ret_item(const int tid, const Params& p, int l, int b, int h, unsigned char* smem) {
    const int lane = tid & 63, wid = tid >> 6, quad = lane >> 4, l15 = lane & 15;
    bf16_t* Qs = (bf16_t*)smem;
    bf16_t* Ks = Qs + 32 * 136;
    bf16_t* Kt = Ks + 32 * 136;
    bf16_t* Vt = Kt + 128 * 40;
    bf16_t* Ss = Vt + 256 * 40;
    bf16_t* Rt = Ss + 32 * 40;
    float* Sp = (float*)(Rt + 256 * 136);
    float* Sf = Sp + 512;
    const bf16_t* P = (const bf16_t*)(p.ws + P_OFF) + (size_t)b * S_ * PW;
    bf16_t* Y = (bf16_t*)p.out + (size_t)b * S_ * 2048;
    const float lg2 = log2f(1.0f - exp2f(-5.0f - (float)h));
    const float gC = exp2f(lg2 * 32.f);
    for (int i = tid; i < 256 * 136 / 2; i += 512) ((unsigned*)Rt)[i] = 0u;
    f32x4 accR[8][2];
#pragma unroll
    for (int dt = 0; dt < 8; ++dt) { accR[dt][0] = (f32x4){0.f, 0.f, 0.f, 0.f}; accR[dt][1] = accR[dt][0]; }
    const int ltt = tid >> 4, dg = tid & 15;
    float cfr[4];
#pragma unroll
    for (int q = 0; q < 4; ++q) cfr[q] = exp2f(-(float)(dg + 16 * q) * (13.287712379549449f / 64.f)) * 0.15915494309189535f;
    const float decK = exp2f(lg2 * (float)(31 - ltt));
    const bf16_t* lrow = P + (size_t)ltt * PW + h * 128 + dg;
    const bf16_t* vrow = P + (size_t)ltt * PW + 2816 + h * 256 + dg;
    bf16_t pq1[4], pq2[4], pk1[4], pk2_[4], pv[16], pg[2][4][2];
    const bf16_t* grow = P + 3840 + h * 256 + wid * 32 + l15;
#pragma unroll
    for (int q = 0; q < 4; ++q) { pq1[q] = lrow[1792 + 16 * q]; pq2[q] = lrow[1792 + 64 + 16 * q]; pk1[q] = lrow[2304 + 16 * q]; pk2_[q] = lrow[2304 + 64 + 16 * q]; }
#pragma unroll
    for (int c = 0; c < 16; ++c) pv[c] = vrow[16 * c];
    __syncthreads();
    for (int ch = 0; ch < S_ / 32; ++ch) {
#pragma unroll
        for (int rt = 0; rt < 2; ++rt)
#pragma unroll
            for (int jj = 0; jj < 4; ++jj)
#pragma unroll
                for (int ct = 0; ct < 2; ++ct) pg[rt][jj][ct] = grow[(size_t)(ch * 32 + rt * 16 + quad * 4 + jj) * PW + ct * 16];

        const int t0 = ch * 32;
        {
            const int t = t0 + ltt;
#pragma unroll
            for (int q = 0; q < 4; ++q) {
                float rev = (float)t * cfr[q]; rev -= floorf(rev);
                const float cs = __builtin_amdgcn_cosf(rev), sn = __builtin_amdgcn_sinf(rev);
                const float q1 = bf2f(pq1[q]), q2 = bf2f(pq2[q]), k1 = bf2f(pk1[q]), k2 = bf2f(pk2_[q]);
                const float qa = q1 * cs - q2 * sn, qb = q2 * cs + q1 * sn;
                const float ka = (k1 * cs - k2 * sn) * 0.08838834764831845f, kb = (k2 * cs + k1 * sn) * 0.08838834764831845f;
                const int d = dg + 16 * q;
                Qs[ltt * 136 + d] = f2bf(qa); Qs[ltt * 136 + 64 + d] = f2bf(qb);
                Ks[ltt * 136 + d] = f2bf(ka); Ks[ltt * 136 + 64 + d] = f2bf(kb);
                Kt[d * 40 + ltt] = f2bf(ka * decK); Kt[(64 + d) * 40 + ltt] = f2bf(kb * decK);
            }
#pragma unroll
            for (int c = 0; c < 16; ++c) Vt[(dg + 16 * c) * 40 + ltt] = pv[c];
        }
        __syncthreads();
        if (ch + 1 < S_ / 32) {
            const size_t adv = (size_t)(t0 + 32) * PW;
#pragma unroll
            for (int q = 0; q < 4; ++q) { pq1[q] = lrow[adv + 1792 + 16 * q]; pq2[q] = lrow[adv + 1792 + 64 + 16 * q]; pk1[q] = lrow[adv + 2304 + 16 * q]; pk2_[q] = lrow[adv + 2304 + 64 + 16 * q]; }
#pragma unroll
            for (int c = 0; c < 16; ++c) pv[c] = vrow[adv + 16 * c];
        }
        if (wid < 4) {
            const int ri = wid & 1, cj = wid >> 1;
            f32x4 sc = {0.f, 0.f, 0.f, 0.f};
#pragma unroll
            for (int ks = 0; ks < 4; ++ks) { const bf16x8 a = *(const bf16x8*)(Qs + (ri * 16 + l15) * 136 + ks * 32 + quad * 8); const bf16x8 bb = *(const bf16x8*)(Ks + (cj * 16 + l15) * 136 + ks * 32 + quad * 8);
                sc = MFMA16(a, bb, sc); }
#pragma unroll
            for (int jj = 0; jj < 4; ++jj) { const int i = ri * 16 + quad * 4 + jj, j = cj * 16 + l15; const int rel = i - j;
                const float val = (rel >= 0) ? sc[jj] * exp2f(lg2 * (float)rel) : 0.f;
                Ss[i * 40 + j] = f2bf(val); }
        }
        f32x4 ao[2][2];
        ao[0][0] = (f32x4){0.f, 0.f, 0.f, 0.f}; ao[0][1] = ao[0][0]; ao[1][0] = ao[0][0]; ao[1][1] = ao[0][0];
#pragma unroll
        for (int ks = 0; ks < 4; ++ks) {
            const bf16x8 a0 = *(const bf16x8*)(Qs + l15 * 136 + ks * 32 + quad * 8), a1 = *(const bf16x8*)(Qs + (16 + l15) * 136 + ks * 32 + quad * 8);
#pragma unroll
            for (int ct = 0; ct < 2; ++ct) { const bf16x8 bb = *(const bf16x8*)(Rt + (wid * 32 + ct * 16 + l15) * 136 + ks * 32 + quad * 8);
                ao[0][ct] = MFMA16(a0, bb, ao[0][ct]); ao[1][ct] = MFMA16(a1, bb, ao[1][ct]); }
        }
#pragma unroll
        for (int rt = 0; rt < 2; ++rt)
#pragma unroll
            for (int jj = 0; jj < 4; ++jj) { const float s = exp2f(lg2 * (float)(rt * 16 + quad * 4 + jj + 1)); ao[rt][0][jj] *= s; ao[rt][1][jj] *= s; }
        __syncthreads();
        {
            bf16x8 bv[2];
#pragma unroll
            for (int ct = 0; ct < 2; ++ct) bv[ct] = *(const bf16x8*)(Vt + (wid * 32 + ct * 16 + l15) * 40 + quad * 8);
#pragma unroll
            for (int rt = 0; rt < 2; ++rt) { const bf16x8 a = *(const bf16x8*)(Ss + (rt * 16 + l15) * 40 + quad * 8);
                ao[rt][0] = MFMA16(a, bv[0], ao[rt][0]); ao[rt][1] = MFMA16(a, bv[1], ao[rt][1]); }
#pragma unroll
            for (int dt = 0; dt < 8; ++dt) { const bf16x8 a = *(const bf16x8*)(Kt + (dt * 16 + l15) * 40 + quad * 8);
#pragma unroll
                for (int ct = 0; ct < 2; ++ct) { accR[dt][ct] = accR[dt][ct] * gC; accR[dt][ct] = MFMA16(a, bv[ct], accR[dt][ct]);
                    st_bf4(Rt + (wid * 32 + ct * 16 + l15) * 136 + dt * 16 + quad * 4, accR[dt][ct]); } }
        }
#pragma unroll
        for (int rt = 0; rt < 2; ++rt)
#pragma unroll
            for (int jj = 0; jj < 4; ++jj) { const float x0 = ao[rt][0][jj], x1 = ao[rt][1][jj];
                float s = x0 + x1, ss = x0 * x0 + x1 * x1; s = sum16(s); ss = sum16(ss);
                if (l15 == 0) { const int i = rt * 16 + quad * 4 + jj; Sp[(i * 8 + wid) * 2] = s; Sp[(i * 8 + wid) * 2 + 1] = ss; } }
        __syncthreads();
        if (tid < 32) { float s = 0.f, ss = 0.f;
#pragma unroll
            for (int w = 0; w < 8; ++w) { s += Sp[(tid * 8 + w) * 2]; ss += Sp[(tid * 8 + w) * 2 + 1]; }
            const float mean = s * (1.f / 256.f); const float var = fmaxf(ss * (1.f / 256.f) - mean * mean, 0.f);
            Sf[tid * 2] = mean; Sf[tid * 2 + 1] = rsqrtf(var + 1e-5f); }
        __syncthreads();
#pragma unroll
        for (int rt = 0; rt < 2; ++rt)
#pragma unroll
            for (int jj = 0; jj < 4; ++jj) { const int i = rt * 16 + quad * 4 + jj; const float mean = Sf[i * 2], rstd = Sf[i * 2 + 1]; const size_t t = (size_t)(t0 + i);
#pragma unroll
                for (int ct = 0; ct < 2; ++ct) { const int e = wid * 32 + ct * 16 + l15;
                    const float g = bf2f(pg[rt][jj][ct]);
                    const float y = g * sigmoidf_(g) * ((ao[rt][ct][jj] - mean) * rstd);
                    Y[t * 2048 + 512 + h * 256 + e] = f2bf(y); } }
    }
}

__device__ __forceinline__ void s5_wave(const int tid, const Params& p, int l, int b, int g, unsigned char* wsm) {
    const int lane = tid & 63, quad = lane >> 4, l15 = lane & 15;
    float* U = (float*)wsm;
    bf16_t* X = (bf16_t*)(wsm + 2048);
    const bf16_t* P = (const bf16_t*)(p.ws + P_OFF) + (size_t)b * S_ * PW + 4864 + g * 16;
    bf16_t* Cp = (bf16_t*)(p.ws + CPRE_OFF) + (size_t)b * S_ * 512 + g * 16;
    const int lg = l * 32 + g;
    const float dt = expf(p.c_log_dt[lg]);
    const float lr = p.c_lam_re[lg * 64 + lane], li = p.c_lam_im[lg * 64 + lane];
    const float em1 = expm1f(lr * dt);
    const float th = li * dt;
    const float cth = cosf(th), sth = sinf(th), sh = sinf(0.5f * th);
    const float abr = (em1 + 1.0f) * cth, abi = (em1 + 1.0f) * sth;
    const float abr_m1 = em1 * cth - 2.0f * sh * sh;
    const float den = lr * lr + li * li;
    const float fre = (abr_m1 * lr + abi * li) / den, fim = (abi * lr - abr_m1 * li) / den;
    f32x2 bbr[8], bbi[8];
#pragma unroll
    for (int c4 = 0; c4 < 4; ++c4) { const f32x4 br = *(const f32x4*)(p.c_b_re + ((size_t)lg * 64 + lane) * 16 + c4 * 4), bi = *(const f32x4*)(p.c_b_im + ((size_t)lg * 64 + lane) * 16 + c4 * 4);
#pragma unroll
        for (int j = 0; j < 2; ++j) { bbr[c4 * 2 + j] = (f32x2){fre * br[2 * j] - fim * bi[2 * j], fre * br[2 * j + 1] - fim * bi[2 * j + 1]};
                                      bbi[c4 * 2 + j] = (f32x2){fre * bi[2 * j] + fim * br[2 * j], fre * bi[2 * j + 1] + fim * br[2 * j + 1]}; } }
    bf16x8 Cf[4];
#pragma unroll
    for (int ks = 0; ks < 4; ++ks)
#pragma unroll
        for (int jj = 0; jj < 8; ++jj) { const int k = (ks & 1) * 32 + quad * 8 + jj;
            const float v = (ks < 2) ? p.c_c_re[((size_t)lg * 16 + l15) * 64 + k] : -p.c_c_im[((size_t)lg * 16 + l15) * 64 + k];
            Cf[ks][jj] = (short)f2bf(v); }
    const float dsk = p.c_d[lg * 16 + l15];
    float xr = 0.f, xi = 0.f;
    const int utt = lane >> 1, uh = lane & 1;
    u32x4 upre = *(const u32x4*)(P + (size_t)utt * PW + uh * 8);
    for (int ch = 0; ch < S_ / 32; ++ch) {
        const int t0 = ch * 32;
        { const u32x4 w = upre;
          *(f32x4*)(U + utt * 16 + uh * 8) = (f32x4){bflo(w.x), bfhi(w.x), bflo(w.y), bfhi(w.y)};
          *(f32x4*)(U + utt * 16 + uh * 8 + 4) = (f32x4){bflo(w.z), bfhi(w.z), bflo(w.w), bfhi(w.w)}; }
        if (ch + 1 < S_ / 32) upre = *(const u32x4*)(P + (size_t)(t0 + 32 + utt) * PW + uh * 8);
        wave_lds_fence();
#pragma unroll 4
        for (int tt = 0; tt < 32; ++tt) {
            const f32x4 u0 = *(const f32x4*)(U + tt * 16), u1 = *(const f32x4*)(U + tt * 16 + 4), u2 = *(const f32x4*)(U + tt * 16 + 8), u3 = *(const f32x4*)(U + tt * 16 + 12);
            const f32x2 uu[8] = {{u0[0], u0[1]}, {u0[2], u0[3]}, {u1[0], u1[1]}, {u1[2], u1[3]}, {u2[0], u2[1]}, {u2[2], u2[3]}, {u3[0], u3[1]}, {u3[2], u3[3]}};
            f32x2 br2 = bbr[0] * uu[0], bi2 = bbi[0] * uu[0];
#pragma unroll
            for (int j = 1; j < 8; ++j) { br2 = br2 + bbr[j] * uu[j]; bi2 = bi2 + bbi[j] * uu[j]; }
            const float br = br2[0] + br2[1], bi = bi2[0] + bi2[1];
            const float nr = abr * xr - abi * xi + br, ni = abr * xi + abi * xr + bi;
            xr = nr; xi = ni;
            X[tt * 136 + lane] = f2bf(xr); X[tt * 136 + 64 + lane] = f2bf(xi);
        }
        wave_lds_fence();
#pragma unroll
        for (int rt = 0; rt < 2; ++rt) {
            f32x4 acc = {0.f, 0.f, 0.f, 0.f};
#pragma unroll
            for (int ks = 0; ks < 4; ++ks) { const bf16x8 a = *(const bf16x8*)(X + (rt * 16 + l15) * 136 + ks * 32 + quad * 8); acc = MFMA16(a, Cf[ks], acc); }
#pragma unroll
            for (int jj = 0; jj < 4; ++jj) { const int tt = rt * 16 + quad * 4 + jj;
                const float y = acc[jj] + dsk * U[tt * 16 + l15];
                const float gl = 0.5f * y * (1.0f + tanhf_(0.7978845608028654f * (y + 0.044715f * y * y * y)));
                Cp[(size_t)(t0 + tt) * 512 + l15] = f2bf(gl); }
        }
        wave_lds_fence();
    }
}


#ifdef DBG_STOP
__device__ __forceinline__ void phase_dump(const int tid, const int bid, const int gsz, const Params& p, int mode) {
    const int lane = tid & 63, wid = tid >> 6;
    const bf16_t* Pj = (const bf16_t*)(p.ws + P_OFF); const bf16_t* Cp = (const bf16_t*)(p.ws + CPRE_OFF); const bf16_t* Xb = (const bf16_t*)(p.ws + XBF_OFF);
    const bf16_t* Mg = (const bf16_t*)(p.ws + MG_OFF);
    for (int row = bid * 8 + wid; row < T_; row += gsz * 8) {
        float v[16];
#pragma unroll
        for (int j = 0; j < 16; ++j) { const int c = lane + 64 * j; float a = 0.f;
            if (mode == 1) { for (int k = 0; k < 5; ++k) a += bf2f(Pj[(size_t)row * PW + c + 1024 * k]); a += bf2f(Pj[(size_t)row * PW + 5120 + (c & 255)]); }
            if (mode == 2) { const bf16_t* Y = (const bf16_t*)p.out; a = bf2f(Y[(size_t)row * 2048 + c]) + bf2f(Y[(size_t)row * 2048 + 1024 + (c & 511)]) + bf2f(Cp[(size_t)row * 512 + (c & 511)]); }
            if (mode == 3) { const bf16_t* Y = (const bf16_t*)p.out; a = bf2f(Y[(size_t)row * 2048 + 1024 + c]) + bf2f(Pj[(size_t)row * 3072 + c]) + bf2f(Pj[(size_t)row * 3072 + 1024 + c]) + bf2f(Pj[(size_t)row * 3072 + 2048 + c]); }
            if (mode == 21) { const bf16_t* Y = (const bf16_t*)p.out; a = bf2f(Y[(size_t)row * 2048 + (c & 511)]); }
            if (mode == 22) { const bf16_t* Y = (const bf16_t*)p.out; a = bf2f(Y[(size_t)row * 2048 + 512 + c]); }
            if (mode == 23) a = bf2f(Cp[(size_t)row * 512 + (c & 511)]);
            if (mode == 4) a = bf2f(Mg[(size_t)row * 1024 + c]);
            if (mode == 5) a = p.out[(size_t)row * 1024 + c];
            if (mode == 6) a = bf2f(Xb[(size_t)row * 1024 + c]);
            if (mode == 7) { for (int k = 0; k < 4; ++k) a += bf2f(Pj[(size_t)row * 4096 + c + 1024 * k]); }
            v[j] = a; }
        asm volatile("s_waitcnt vmcnt(0)" ::: "memory");
#pragma unroll
        for (int j = 0; j < 16; ++j) p.out[(size_t)row * 1024 + lane + 64 * j] = v[j];
    }
}
#endif
constexpr int PH_PER_LAYER = 10, N_PHASES = 2 * PH_PER_LAYER;
typedef const __attribute__((address_space(4))) Params* KP;
template <int PHC> __device__ __forceinline__ void run_phase(KP kp, unsigned char* smem) {
    int ph = PHC;
    int tid = threadIdx.x; asm volatile("" : "+v"(tid));
    int bid = blockIdx.x, gsz = gridDim.x;
    asm volatile("" : "+s"(kp), "+s"(bid), "+s"(gsz));
    Params p;
    { const __attribute__((address_space(4))) unsigned long long* s_ = (const __attribute__((address_space(4))) unsigned long long*)kp;
#define PIN_(i) ((const float*)(const __attribute__((address_space(1))) float*)s_[i])
      p.x = PIN_(0);
      p.w_in = PIN_(1);
      p.b_gate = PIN_(2);
      p.a_shift = PIN_(3);
      p.a_w0 = PIN_(4);
      p.a_w2 = PIN_(5);
      p.a_a0 = PIN_(6);
      p.a_a2 = PIN_(7);
      p.a_g2 = PIN_(8);
      p.a_kk = PIN_(9);
      p.a_ka = PIN_(10);
      p.a_rk = PIN_(11);
      p.a_lnx_g = PIN_(12);
      p.a_lnx_b = PIN_(13);
      p.c_lam_re = PIN_(14);
      p.c_lam_im = PIN_(15);
      p.c_log_dt = PIN_(16);
      p.c_b_re = PIN_(17);
      p.c_b_im = PIN_(18);
      p.c_c_re = PIN_(19);
      p.c_c_im = PIN_(20);
      p.c_d = PIN_(21);
      p.c_w_glu = PIN_(22);
      p.c_b_glu = PIN_(23);
      p.w_branch = PIN_(24);
      p.w_out = PIN_(25);
      p.ln1_g = PIN_(26);
      p.ln1_b = PIN_(27);
      p.w_ff1 = PIN_(28);
      p.w_ff2 = PIN_(29);
      p.ln2_g = PIN_(30);
      p.ln2_b = PIN_(31);
#undef PIN_
      p.out = (float*)(__attribute__((address_space(1))) float*)s_[32];
      p.ws = (unsigned char*)(__attribute__((address_space(1))) unsigned char*)s_[33]; }
    constexpr int l = PHC / PH_PER_LAYER, q = PHC % PH_PER_LAYER;
    bf16_t* W = (bf16_t*)(p.ws + W_OFF + (size_t)l * 40 * MiB);
    bf16_t* Xbf = (bf16_t*)(p.ws + XBF_OFF);
    bf16_t* Pj = (bf16_t*)(p.ws + P_OFF);
    bf16_t* Gt = (bf16_t*)(p.ws + GT_OFF);
    bf16_t* Mg = (bf16_t*)(p.ws + MG_OFF);
    bf16_t* Hb = (bf16_t*)(p.ws + H_OFF);
    bf16_t* Cp = (bf16_t*)(p.ws + CPRE_OFF);
    bf16_t* Yb = (bf16_t*)p.out;
    bf16_t* Pre = (bf16_t*)(p.ws + PRE_OFF);
#ifdef ONLY_Q
    if (q != ONLY_Q) return;
#endif
#ifdef DBG_STOP
    if (ph == DBG_STOP) { phase_dump(tid, bid, gsz, p, DBG_MODE); return; }
    if (ph > DBG_STOP) return;
#endif
    switch (q) {
    case 0: if (l == 0) phase_convert(tid, bid, gsz, p, 0, smem); break;
    case 1: { EpiStore E; E.O = Pj; E.ldc = PW; run_gemm(tid, bid, gsz, smem, Xbf, 1024, W + WT_IN, 1024, PW, 1024, E); } break;
    case 2:
        for (int item = bid; item < 256; item += gsz) {
            asm volatile("" : "+v"(tid));
#ifdef ONLY_MIX
            if (ONLY_MIX == 0) rwkv_item(tid, p, l, item >> 3, item & 7, smem);
            if (ONLY_MIX == 1) ret_item(tid, p, l, (item - 128) >> 2, (item - 128) & 3, smem);
            if (ONLY_MIX == 2) { const int bg = (item - 192) * 8 + (tid >> 6); s5_wave(tid, p, l, bg >> 5, bg & 31, smem + (tid >> 6) * 10752); }
#else
            if (item < 128) rwkv_item(tid, p, l, item >> 3, item & 7, smem);
            else if (item < 192) ret_item(tid, p, l, (item - 128) >> 2, (item - 128) & 3, smem);
            else { const int bg = (item - 192) * 8 + (tid >> 6); s5_wave(tid, p, l, bg >> 5, bg & 31, smem + (tid >> 6) * 10752); }
#endif
            __syncthreads();
        }
        if (l == 0 && gsz == 256 && bid >= 128) phase_convert(tid, bid - 128, 128, p, 1, smem);
        else if (l == 0 && gsz != 256) phase_convert(tid, bid, gsz, p, 1, smem);
        break;
    case 3: {
        EpiGlu E; E.O = Yb; E.ldc = 2048; E.ocol0 = 1536; E.Yin = Cp; E.ldy = 512; E.bias = p.c_b_glu + l * 512;
        run_gemm(tid, bid, gsz, smem, Cp, 512, W + WT_GLU, 512, 512, 512, E);
        EpiSigmoid E2; E2.O = Gt; E2.ldc = 3072; E2.bias = p.b_gate + l * 3072;
        run_gemm(tid, bid, gsz, smem, Xbf, 1024, W + WT_IN + (size_t)PW * 1024, 1024, 3072, 1024, E2);
    } break;
    case 4: { EpiMerge E; E.O = Mg; E.G = Gt; run_gemm(tid, bid, gsz, smem, Yb, 2048, W + WT_BR, 2048, 1024, 2048, E); } break;
    case 5: { EpiResid E; E.C = Pre; E.X = Xbf; run_gemm(tid, bid, gsz, smem, Mg, 1024, W + WT_OUT, 1024, 1024, 1024, E); } break;
    case 6: phase_ln(tid, bid, gsz, Pre, p.ln1_g + l * 1024, p.ln1_b + l * 1024, Xbf, nullptr); break;
    case 7: { EpiSqRelu E; E.O = Hb; E.ldc = 4096; run_gemm(tid, bid, gsz, smem, Xbf, 1024, W + WT_FF1, 1024, 4096, 1024, E); } break;
    case 8: { EpiResid E; E.C = Pre; E.X = Xbf; run_gemm(tid, bid, gsz, smem, Hb, 4096, W + WT_FF2, 4096, 1024, 4096, E); } break;
    case 9: phase_ln(tid, bid, gsz, Pre, p.ln2_g + l * 1024, p.ln2_b + l * 1024, Xbf, (l == 1) ? p.out : nullptr); break;
    }
}

template <int LO, int HI> __device__ __forceinline__ void run_range(KP kp, unsigned char* smem, const XcdBarrier& xb) {
    if constexpr (LO < HI) {
        run_phase<LO>(kp, smem);
        if constexpr (LO + 1 < HI) {
            if constexpr (LO != PH_PER_LAYER) xcd_barrier(xb);
            run_range<LO + 1, HI>(kp, smem, xb);
        }
    }
}
__global__ void __launch_bounds__(512, 2) mega_fwd(Params p) {
    extern __shared__ __attribute__((aligned(16))) unsigned char smem[];
    KP kp = (KP)__builtin_amdgcn_kernarg_segment_ptr();
    volatile LAS unsigned* st = (volatile LAS unsigned*)((LAS unsigned char*)smem + LDS_BYTES - 16);
    if (threadIdx.x == 0) { st[0] = 0u; st[1] = 0u; }
    __syncthreads();
    const XcdBarrier xb = xcd_barrier_post((unsigned*)(p.ws + BAR_OFF), st);
    if (p.ws == nullptr) cg::this_grid().sync();
    run_range<0, N_PHASES>(kp, smem, xb);
}
#if MK_MULTI
template <int PH> __global__ void __launch_bounds__(512, 2) phase_kernel(Params p) {
    extern __shared__ __attribute__((aligned(16))) unsigned char smem[];
    KP kp = (KP)__builtin_amdgcn_kernarg_segment_ptr();
    run_phase<PH>(kp, smem);
}
template <int PH> static void launch_phases(int grid, const Params& p, hipStream_t stream) {
    if constexpr (PH < N_PHASES) {
        (void)hipFuncSetAttribute((const void*)phase_kernel<PH>, hipFuncAttributeMaxDynamicSharedMemorySize, LDS_BYTES);
        hipLaunchKernelGGL(phase_kernel<PH>, dim3(grid), dim3(512), LDS_BYTES, stream, p);
        launch_phases<PH + 1>(grid, p, stream);
    }
}
#endif

extern "C" void kernel_launch(void* const* d_in, const int* in_sizes, int n_in, void* d_out, int out_size, void* d_ws, size_t ws_size, hipStream_t stream) {
    static int grid = 0;
    if (grid == 0) {
        int dev = 0, cus = 0, per_cu = 0;
        if (n_in != 32 || out_size != T_ * D_ || ws_size < WS_END) { fprintf(stderr, "kernel_launch: unexpected problem (n_in %d, out %d, ws %zu)\n", n_in, out_size, ws_size); grid = -1; return; }
        hipGetDevice(&dev);
        hipDeviceGetAttribute(&cus, hipDeviceAttributeMultiprocessorCount, dev);
        if (hipFuncSetAttribute((const void*)mega_fwd, hipFuncAttributeMaxDynamicSharedMemorySize, LDS_BYTES) != hipSuccess) fprintf(stderr, "kernel_launch: hipFuncSetAttribute failed\n");
        hipOccupancyMaxActiveBlocksPerMultiprocessor(&per_cu, (const void*)mega_fwd, 512, LDS_BYTES);
        (void)hipGetLastError();
        if (per_cu < 1) { fprintf(stderr, "kernel_launch: occupancy query says %d\n", per_cu); per_cu = 1; }
        grid = cus;
    }
    if (grid < 0) return;
    Params p{};
    const float** pp = (const float**)&p;
    for (int i = 0; i < 32; ++i) pp[i] = (const float*)d_in[i];
    p.out = (float*)d_out; p.ws = (unsigned char*)d_ws;
#if MK_MULTI
    launch_phases<0>(grid, p, stream);
#else
    (void)hipMemsetAsync((unsigned char*)d_ws + BAR_OFF, 0, XCD_BAR_WORDS * sizeof(unsigned), stream);
    void* args[] = {&p};
    hipError_t e = hipLaunchCooperativeKernel((const void*)mega_fwd, dim3(grid), dim3(512), args, LDS_BYTES, stream);
    if (e != hipSuccess) fprintf(stderr, "cooperative launch failed: %s (grid %d)\n", hipGetErrorString(e), grid);
#endif
}
```

```cpp
#include <hip/hip_runtime.h>
#include <hip/hip_cooperative_groups.h>
#include <cstdio>
#include <cstdint>
namespace cg = cooperative_groups;

#define LAS __attribute__((address_space(3)))
typedef unsigned short bf16_t;
typedef short bf16x8 __attribute__((ext_vector_type(8)));
typedef float f32x4 __attribute__((ext_vector_type(4)));
typedef float f32x2 __attribute__((ext_vector_type(2)));
typedef unsigned u32x4 __attribute__((ext_vector_type(4)));
typedef unsigned u32x2 __attribute__((ext_vector_type(2)));

#ifndef MK_MULTI
#define MK_MULTI 0
#endif

constexpr int T_ = 32768, S_ = 2048, D_ = 1024;
constexpr int PW = 5376;
constexpr int PTOT = 8448;
constexpr int LDS_BYTES = 163840;
constexpr size_t MiB = 1024ull * 1024ull;
constexpr size_t W_OFF = 0;
constexpr size_t WT_IN = 0, WT_GLU = WT_IN + (size_t)8448 * 1024, WT_BR = WT_GLU + (size_t)512 * 512, WT_OUT = WT_BR + (size_t)1024 * 2048,
                 WT_FF1 = WT_OUT + (size_t)1024 * 1024, WT_FF2 = WT_FF1 + (size_t)4096 * 1024;
constexpr size_t XBF_OFF = 80 * MiB;
constexpr size_t P_OFF = 144 * MiB;
constexpr size_t GT_OFF = P_OFF, MG_OFF = P_OFF + 192 * MiB, H_OFF = P_OFF, PRE_OFF = P_OFF + 256 * MiB;
constexpr size_t CPRE_OFF = 480 * MiB;
constexpr size_t WS_END = 512 * MiB;
constexpr size_t BAR_OFF = 40 * MiB - 65536;
constexpr float DN_ALPHA = 1.41421356237f;

struct Params {
    const float* x; const float* w_in; const float* b_gate; const float* a_shift; const float* a_w0; const float* a_w2;
    const float* a_a0; const float* a_a2; const float* a_g2; const float* a_kk; const float* a_ka; const float* a_rk;
    const float* a_lnx_g; const float* a_lnx_b; const float* c_lam_re; const float* c_lam_im; const float* c_log_dt;
    const float* c_b_re; const float* c_b_im; const float* c_c_re; const float* c_c_im; const float* c_d;
    const float* c_w_glu; const float* c_b_glu; const float* w_branch; const float* w_out; const float* ln1_g; const float* ln1_b;
    const float* w_ff1; const float* w_ff2; const float* ln2_g; const float* ln2_b;
    float* out; unsigned char* ws;
};

__device__ __forceinline__ float bf2f(bf16_t b) { return __uint_as_float(((unsigned)b) << 16); }
__device__ __forceinline__ float bflo(unsigned w) { return __uint_as_float(w << 16); }
__device__ __forceinline__ float bfhi(unsigned w) { return __uint_as_float(w & 0xffff0000u); }
typedef __bf16 bf16x2_t __attribute__((ext_vector_type(2)));
__device__ __forceinline__ unsigned pk2(float lo, float hi) { const f32x2 v = {lo, hi}; const bf16x2_t b = __builtin_convertvector(v, bf16x2_t); return __builtin_bit_cast(unsigned, b); }
__device__ __forceinline__ bf16_t f2bf(float f) { const __bf16 b = (__bf16)f; return __builtin_bit_cast(unsigned short, b); }
__device__ __forceinline__ float sigmoidf_(float x) { return __builtin_amdgcn_rcpf(1.0f + __builtin_amdgcn_exp2f(-1.4426950408889634f * x)); }
__device__ __forceinline__ float tanhf_(float x) { return 1.0f - 2.0f * __builtin_amdgcn_rcpf(1.0f + __builtin_amdgcn_exp2f(2.8853900817779268f * x)); }
template <int CTRL> __device__ __forceinline__ float dppf(float x) { return __int_as_float(__builtin_amdgcn_update_dpp(0, __float_as_int(x), CTRL, 0xF, 0xF, false)); }
__device__ __forceinline__ float sum8(float x) { x += dppf<0xB1>(x); x += dppf<0x4E>(x); x += dppf<0x141>(x); return x; }
__device__ __forceinline__ float sum16(float x) { x += dppf<0xB1>(x); x += dppf<0x4E>(x); x += dppf<0x141>(x); x += dppf<0x140>(x); return x; }
__device__ __forceinline__ float wave_sum(float v) {
#pragma unroll
    for (int o = 1; o < 64; o <<= 1) v += __shfl_xor(v, o);
    return v;
}
__device__ __forceinline__ void wave_lds_fence() { asm volatile("s_waitcnt lgkmcnt(0)" ::: "memory"); __builtin_amdgcn_wave_barrier(); asm volatile("" ::: "memory"); }
#define MFMA16(a, b, c) __builtin_amdgcn_mfma_f32_16x16x32_bf16((a), (b), (c), 0, 0, 0)


#define XB_TMO      128
#define XB_XCNT(j)  (256  + 64 * (j))
#define XB_XSUB(j)  (1280 + 64 * (j))
#define XB_XGEN(j)  (2304 + 64 * (j))
#define XB_TOP      3328
#define XB_TOPGEN   3392
#define XCD_BAR_WORDS 3456
#define XB_SPIN_CAP (1u << 22)
__device__ __forceinline__ unsigned xb_ld(unsigned* p)              { return __hip_atomic_load(p, __ATOMIC_RELAXED, __HIP_MEMORY_SCOPE_AGENT); }
__device__ __forceinline__ unsigned xb_add(unsigned* p, unsigned v) { return __hip_atomic_fetch_add(p, v, __ATOMIC_RELAXED, __HIP_MEMORY_SCOPE_AGENT); }
__device__ __forceinline__ unsigned xb_xcc_id() { return (unsigned)__builtin_amdgcn_s_getreg((3 << 11) | 20) & 0xFu; }
#define XB_SPIN(cond, bar) do { unsigned _sp = 0; while (cond) { __builtin_amdgcn_s_sleep(1); \
    if ((++_sp & 255u) == 0u) { if (xb_ld(&(bar)[XB_TMO])) break; if (_sp > XB_SPIN_CAP) { atomicAdd(&(bar)[XB_TMO], 1u); break; } } } } while (0)
struct XcdBarrier { unsigned* bar; unsigned x; volatile LAS unsigned* st; };
__device__ __forceinline__ XcdBarrier xcd_barrier_post(unsigned* bar, volatile LAS unsigned* st) {
    XcdBarrier b; b.bar = bar; b.x = xb_xcc_id(); b.st = st;
    if (threadIdx.x == 0) (void)xb_add(&bar[XB_XCNT(b.x)], 1u);
    return b;
}
__device__ __forceinline__ void xcd_barrier_complete(unsigned* bar, unsigned x, unsigned& nloc, unsigned& nx) {
    const unsigned G = gridDim.x * gridDim.y * gridDim.z;
    unsigned sum, cnt, mine, sp = 0u;
    for (;;) {
        sum = 0u; cnt = 0u; mine = 0u;
#pragma unroll
        for (unsigned j = 0; j < 16; ++j) { const unsigned c = xb_ld(&bar[XB_XCNT(j)]); sum += c; cnt += (c > 0u) ? 1u : 0u; mine = (j == x) ? c : mine; }
        if (sum == G) break;
        __builtin_amdgcn_s_sleep(1);
        if ((++sp & 255u) == 0u) { if (xb_ld(&bar[XB_TMO])) break; if (sp > XB_SPIN_CAP) { atomicAdd(&bar[XB_TMO], 1u); break; } }
    }
    nloc = mine > 0u ? mine : 1u; nx = cnt > 0u ? cnt : 1u;
}
__device__ __forceinline__ void xcd_barrier(const XcdBarrier& b) {
    asm volatile("s_waitcnt vmcnt(0)" ::: "memory");
    __syncthreads();
    if (threadIdx.x == 0) {
        unsigned* bar = b.bar;
        __builtin_amdgcn_s_waitcnt(0);
        unsigned nloc = b.st[0], nx = b.st[1];
        if (nloc == 0u) { xcd_barrier_complete(bar, b.x, nloc, nx); b.st[0] = nloc; b.st[1] = nx; }
        const unsigned old = xb_add(&bar[XB_XSUB(b.x)], 1u);
        const unsigned gen = old / nloc;
        if (old + 1u == (gen + 1u) * nloc) {
            __builtin_amdgcn_fence(__ATOMIC_RELEASE, "agent");
            asm volatile("s_waitcnt vmcnt(0)" ::: "memory");
            const unsigned og = xb_add(&bar[XB_TOP], 1u);
            const unsigned tg = og / nx;
            if (og + 1u == (tg + 1u) * nx) xb_add(&bar[XB_TOPGEN], 1u);
            else XB_SPIN(xb_ld(&bar[XB_TOPGEN]) == tg, bar);
            __builtin_amdgcn_fence(__ATOMIC_ACQUIRE, "agent");
            xb_add(&bar[XB_XGEN(b.x)], 1u);
            asm volatile("s_waitcnt vmcnt(0)" ::: "memory");
        } else {
            XB_SPIN(xb_ld(&bar[XB_XGEN(b.x)]) == gen, bar);
            __builtin_amdgcn_fence(__ATOMIC_ACQUIRE, "agent");
            asm volatile("s_waitcnt vmcnt(0)" ::: "memory");
        }
    }
    __syncthreads();
}

namespace pg8 {
#ifndef MK_SP2
#define MK_SP2 true
#endif
#ifndef MK_ALIGN
#define MK_ALIGN true
#endif
constexpr bool GEMM_SP2 = MK_SP2, GEMM_ALIGN = MK_ALIGN;
constexpr int BM = 256, BK = 64, HALF = 128, HTB = HALF * BK * 2, STAGE_BYTES = 8 * HTB, NXCD = 8, WGM = 8;
__device__ __forceinline__ int lds_byte(int r, int c) { const int st = (r >> 4) * 2 + (c >> 5), rr = r & 15, cc = c & 31, ob = rr * 64 + cc * 2; return st * 1024 + (ob ^ (((ob >> 9) & 1) << 5)); }
__device__ __forceinline__ void stage_rc(int b, int& R, int& C) { const int st = b / 1024, sb = b % 1024, swz = sb ^ (((sb >> 9) & 1) << 5); R = (st >> 1) * 16 + swz / 64; C = (st & 1) * 32 + (swz % 64) / 2; }
__device__ __forceinline__ int perm32(int rho) { const int n = rho >> 4, i = rho & 15; return 8 * (i >> 2) + 4 * n + (i & 3); }
struct Unit { int pm, pn; };
struct Gemm { const bf16_t* A; const bf16_t* Bt; int M, N, K, lda, ldb; };
struct StaticOrder {
    int nM, nN, nwg, G, c;
    __device__ void init(int M, int N, int G_, int c_) { nM = M / BM; nN = N / BM; nwg = nM * nN; G = G_; c = c_; }
    __device__ bool next(int i, Unit& u) const {
        const long L = (long)i * G + c; if (L >= nwg) return false;
        int wgid = (int)L; { const int q = nwg / NXCD, r = nwg % NXCD, xcd = wgid % NXCD, off = wgid / NXCD; wgid = (xcd < r ? xcd * (q + 1) : r * (q + 1) + (xcd - r) * q) + off; }
        const int nig = WGM * nN, gid = wgid / nig, fm = gid * WGM, gsz = (nM - fm) < WGM ? (nM - fm) : WGM;
        u.pm = fm + ((wgid % nig) % gsz); u.pn = (wgid % nig) / gsz; return true;
    }
};
template <class Epi>
__device__ __forceinline__ void gemm_phase(LAS unsigned char* lds, const Gemm g, const StaticOrder& S, const Epi& E, const int tid) {
    const int wid = __builtin_amdgcn_readfirstlane(tid >> 6), lane = tid & 63, wr = wid >> 2, wc = wid & 3, fr = lane & 15, fq = lane >> 4;
    const int K = g.K, nt = K / BK;
    unsigned voffA[2], voffB[2];
#pragma unroll
    for (int i = 0; i < 2; ++i) { int R, C; stage_rc(tid * 16 + i * 8192, R, C); const int Rb = Epi::PERM ? ((R & ~31) + perm32(R & 31)) : R;
        voffA[i] = (unsigned)(R * g.lda + C) * 2u; voffB[i] = (unsigned)(Rb * g.ldb + C) * 2u; }
    const size_t kstep = (size_t)(BK * 2);
    const size_t hA = (size_t)HALF * g.lda * 2, hB = (size_t)HALF * g.ldb * 2;
    const size_t tA = 2 * hA, tB = 2 * hB;
    const unsigned ldsw = (unsigned)wid * 1024u;
    const int aoff = lds_byte(wr * 64 + fr, fq * 8), boff = lds_byte(wc * 32 + fr, fq * 8);
#define PG8_SA(b, h) (((b) * 2 + (h)) * HTB)
#define PG8_SB(b, h) ((4 + (b) * 2 + (h)) * HTB)
#define PG8_STAGE(bufoff, gbase, voff) do { _Pragma("unroll") for (int _i = 0; _i < 2; ++_i) \
        __builtin_amdgcn_global_load_lds((const unsigned*)((const char*)(gbase) + (voff)[_i]), (LAS unsigned*)(lds + (bufoff) + ldsw + _i * 8192), 16, 0, 0); } while (0)
#define PG8_LDA(dst, b, h) do { _Pragma("unroll") for (int m = 0; m < 4; ++m) _Pragma("unroll") for (int k = 0; k < 2; ++k) dst[m][k] = *(const LAS bf16x8*)(lds + PG8_SA(b, h) + aoff + m * 2048 + k * 1024); } while (0)
#define PG8_LDB(dst, b, h) do { _Pragma("unroll") for (int n = 0; n < 2; ++n) _Pragma("unroll") for (int k = 0; k < 2; ++k) dst[n][k] = *(const LAS bf16x8*)(lds + PG8_SB(b, h) + boff + n * 2048 + k * 1024); } while (0)
#define PG8_MMA(ai, bj, At, Bt) do { __builtin_amdgcn_s_setprio(1); _Pragma("unroll") for (int m = 0; m < 4; ++m) _Pragma("unroll") for (int n = 0; n < 2; ++n) _Pragma("unroll") for (int k = 0; k < 2; ++k) \
        acc[ai][bj][m][n] = __builtin_amdgcn_mfma_f32_16x16x32_bf16(Bt[n][k], At[m][k], acc[ai][bj][m][n], 0, 0, 0); __builtin_amdgcn_s_setprio(0); } while (0)
#define PG8_WAIT_V(n) asm volatile("s_waitcnt vmcnt(" #n ")" ::: "memory")
#define PG8_WAIT_L(n) asm volatile("s_waitcnt lgkmcnt(" #n ")" ::: "memory")
#define PG8_BAR __builtin_amdgcn_s_barrier()
#define PG8_SCHED __builtin_amdgcn_sched_barrier(0)
    Unit cur, nxt; int ui = 0;
    if (!S.next(0, cur)) return;
    f32x4 acc[2][2][4][2];
#pragma unroll
    for (int a = 0; a < 2; ++a)
#pragma unroll
        for (int b = 0; b < 2; ++b)
#pragma unroll
            for (int m = 0; m < 4; ++m)
#pragma unroll
                for (int n = 0; n < 2; ++n) acc[a][b][m][n] = (f32x4){0.f, 0.f, 0.f, 0.f};
    bf16x8 At[4][2], B0[2][2], B1[2][2];
    const char* cA = (const char*)g.A + (size_t)cur.pm * tA; const char* cB = (const char*)g.Bt + (size_t)cur.pn * tB;
    if constexpr (GEMM_SP2) {
        PG8_STAGE(PG8_SB(0, 0), cB, voffB); PG8_STAGE(PG8_SB(0, 1), cB + hB, voffB); PG8_STAGE(PG8_SA(0, 0), cA, voffA); PG8_STAGE(PG8_SA(0, 1), cA + hA, voffA);
        if (wr == 1) PG8_BAR;
        PG8_WAIT_V(2); PG8_BAR;
        PG8_STAGE(PG8_SB(1, 0), cB + kstep, voffB); PG8_STAGE(PG8_SA(1, 0), cA + kstep, voffA); PG8_STAGE(PG8_SB(1, 1), cB + hB + kstep, voffB);
        PG8_WAIT_V(6); PG8_BAR;
    } else {
    PG8_STAGE(PG8_SB(0, 0), cB, voffB); PG8_STAGE(PG8_SA(0, 0), cA, voffA); PG8_STAGE(PG8_SB(0, 1), cB + hB, voffB); PG8_STAGE(PG8_SA(0, 1), cA + hA, voffA);
    if (wr == 1) PG8_BAR;
    PG8_WAIT_V(4); PG8_BAR;
    PG8_STAGE(PG8_SB(1, 0), cB + kstep, voffB); PG8_STAGE(PG8_SA(1, 0), cA + kstep, voffA); PG8_STAGE(PG8_SB(1, 1), cB + hB + kstep, voffB);
    PG8_WAIT_V(6); PG8_BAR;
    }
    for (;;) {
        const bool has_next = S.next(ui + 1, nxt);
        const char* nA = has_next ? (const char*)g.A + (size_t)nxt.pm * tA : cA; const char* nB = has_next ? (const char*)g.Bt + (size_t)nxt.pn * tB : cB;
        for (int t = 0; t < nt; t += 2) {
            const bool last = (t == nt - 2);
            const char* a1 = cA + (size_t)(t + 1) * kstep;
            const char* a2 = last ? nA : cA + (size_t)(t + 2) * kstep; const char* b2 = last ? nB : cB + (size_t)(t + 2) * kstep;
            const char* a3 = a2 + kstep; const char* b3 = b2 + kstep;
            if constexpr (Epi::KHOOK) { if (t == 8 || t == 24) E.khook(acc, cur, t, wr, wc, fr, fq); }
            if constexpr (GEMM_SP2) {
            PG8_LDB(B0, 0, 0); PG8_LDB(B1, 0, 1); PG8_SCHED; PG8_LDA(At, 0, 0); PG8_STAGE(PG8_SA(1, 1), a1 + hA, voffA);
            PG8_WAIT_V(8); PG8_WAIT_L(0); PG8_BAR; PG8_MMA(0, 0, At, B0); PG8_MMA(0, 1, At, B1); PG8_BAR; PG8_SCHED;
            PG8_LDA(At, 0, 1); PG8_STAGE(PG8_SB(0, 0), b2, voffB); PG8_STAGE(PG8_SB(0, 1), b2 + hB, voffB); PG8_STAGE(PG8_SA(0, 0), a2, voffA);
            PG8_WAIT_V(8); PG8_WAIT_L(0); PG8_BAR; PG8_MMA(1, 0, At, B0); PG8_MMA(1, 1, At, B1); PG8_BAR; PG8_SCHED;
            PG8_LDB(B0, 1, 0); PG8_LDB(B1, 1, 1); PG8_SCHED; PG8_LDA(At, 1, 0); PG8_STAGE(PG8_SA(0, 1), a2 + hA, voffA);
            PG8_WAIT_V(8); PG8_WAIT_L(0); PG8_BAR; PG8_MMA(0, 0, At, B0); PG8_MMA(0, 1, At, B1); PG8_BAR; PG8_SCHED;
            PG8_LDA(At, 1, 1); PG8_STAGE(PG8_SB(1, 0), b3, voffB); PG8_STAGE(PG8_SB(1, 1), b3 + hB, voffB); PG8_STAGE(PG8_SA(1, 0), a3, voffA);
            PG8_WAIT_V(8); PG8_WAIT_L(0); PG8_BAR; PG8_MMA(1, 0, At, B0); PG8_MMA(1, 1, At, B1); PG8_BAR; PG8_SCHED;
            } else {
            PG8_LDB(B0, 0, 0); PG8_SCHED; PG8_LDA(At, 0, 0); PG8_STAGE(PG8_SA(1, 1), a1 + hA, voffA);
            PG8_WAIT_L(8); PG8_BAR; PG8_WAIT_L(0); PG8_MMA(0, 0, At, B0); PG8_BAR; PG8_SCHED;
            PG8_LDB(B1, 0, 1); PG8_STAGE(PG8_SB(0, 0), b2, voffB);
            PG8_BAR; PG8_WAIT_L(0); PG8_MMA(0, 1, At, B1); PG8_BAR;
            PG8_LDA(At, 0, 1); PG8_STAGE(PG8_SA(0, 0), a2, voffA);
            PG8_BAR; PG8_WAIT_L(0); PG8_MMA(1, 0, At, B0); PG8_BAR; PG8_SCHED;
            PG8_STAGE(PG8_SB(0, 1), b2 + hB, voffB);
            PG8_WAIT_V(6); PG8_BAR; PG8_MMA(1, 1, At, B1); PG8_BAR;
            PG8_LDB(B0, 1, 0); PG8_SCHED; PG8_LDA(At, 1, 0); PG8_STAGE(PG8_SA(0, 1), a2 + hA, voffA);
            PG8_WAIT_L(8); PG8_BAR; PG8_WAIT_L(0); PG8_MMA(0, 0, At, B0); PG8_BAR; PG8_SCHED;
            PG8_LDB(B1, 1, 1); PG8_STAGE(PG8_SB(1, 0), b3, voffB);
            PG8_BAR; PG8_WAIT_L(0); PG8_MMA(0, 1, At, B1); PG8_BAR;
            PG8_LDA(At, 1, 1); PG8_STAGE(PG8_SA(1, 0), a3, voffA);
            PG8_BAR; PG8_WAIT_L(0); PG8_MMA(1, 0, At, B0); PG8_BAR; PG8_SCHED;
            PG8_STAGE(PG8_SB(1, 1), b3 + hB, voffB);
            PG8_WAIT_V(6); PG8_BAR; PG8_MMA(1, 1, At, B1); PG8_BAR;
            }
        }
        if constexpr (GEMM_ALIGN) { if (wr == 0) PG8_BAR; }
        E(acc, cur, wr, wc, fr, fq);
        if (!has_next) break;
#pragma unroll
        for (int a = 0; a < 2; ++a)
#pragma unroll
            for (int b = 0; b < 2; ++b)
#pragma unroll
                for (int m = 0; m < 4; ++m)
#pragma unroll
                    for (int n = 0; n < 2; ++n) acc[a][b][m][n] = (f32x4){0.f, 0.f, 0.f, 0.f};
        cur = nxt; cA = nA; cB = nB; ++ui;
        if constexpr (GEMM_ALIGN) { if (wr == 1) PG8_BAR; }
    }
    PG8_WAIT_V(0);
    if constexpr (!GEMM_ALIGN) { if (wr == 0) PG8_BAR; }
    PG8_BAR;
#undef PG8_SA
#undef PG8_SB
#undef PG8_STAGE
#undef PG8_LDA
#undef PG8_LDB
#undef PG8_MMA
#undef PG8_WAIT_V
#undef PG8_WAIT_L
#undef PG8_BAR
#undef PG8_SCHED
}
}
using pg8::Unit;

#define EPI_FOR_ROWS  _Pragma("unroll") for (int ai = 0; ai < 2; ++ai) _Pragma("unroll") for (int m = 0; m < 4; ++m)
#define EPI_FOR_COLS  _Pragma("unroll") for (int bj = 0; bj < 2; ++bj) _Pragma("unroll") for (int n = 0; n < 2; ++n)
#define EPI_FOR_BJ    _Pragma("unroll") for (int bj = 0; bj < 2; ++bj)
#define EPI_ROW (u.pm * 256 + ai * 128 + wr * 64 + m * 16 + fr)
#define EPI_COL (u.pn * 256 + bj * 128 + wc * 32 + n * 16 + 4 * fq)
#define EPI_COL8 (u.pn * 256 + bj * 128 + wc * 32 + 8 * fq)
typedef f32x4 AccT[2][2][4][2];

__device__ __forceinline__ void st_bf4(bf16_t* p, f32x4 v) { u32x2 w; w.x = pk2(v[0], v[1]); w.y = pk2(v[2], v[3]); *(u32x2*)p = w; }
__device__ __forceinline__ void st_bf8(bf16_t* p, f32x4 v0, f32x4 v1) { u32x4 w; w.x = pk2(v0[0], v0[1]); w.y = pk2(v0[2], v0[3]); w.z = pk2(v1[0], v1[1]); w.w = pk2(v1[2], v1[3]); *(u32x4*)p = w; }
__device__ __forceinline__ f32x4 ld_bf4(const bf16_t* p) { const u32x2 w = *(const u32x2*)p; return (f32x4){bflo(w.x), bfhi(w.x), bflo(w.y), bfhi(w.y)}; }
__device__ __forceinline__ f32x4 bf4lo(u32x4 w) { return (f32x4){bflo(w.x), bfhi(w.x), bflo(w.y), bfhi(w.y)}; }
__device__ __forceinline__ f32x4 bf4hi(u32x4 w) { return (f32x4){bflo(w.z), bfhi(w.z), bflo(w.w), bfhi(w.w)}; }

struct EpiStore {
    static constexpr bool KHOOK = false, PERM = true;
    bf16_t* O; int ldc;
    __device__ __forceinline__ void operator()(const AccT& acc, const Unit& u, int wr, int wc, int fr, int fq) const {
        EPI_FOR_ROWS { bf16_t* rp = O + (size_t)EPI_ROW * ldc; EPI_FOR_BJ st_bf8(rp + EPI_COL8, acc[ai][bj][m][0], acc[ai][bj][m][1]); }
    }
    __device__ __forceinline__ void khook(AccT&, const Unit&, int, int, int, int, int) const {}
};
struct EpiSqRelu {
    static constexpr bool KHOOK = false, PERM = true;
    bf16_t* O; int ldc;
    __device__ __forceinline__ void operator()(const AccT& acc, const Unit& u, int wr, int wc, int fr, int fq) const {
        EPI_FOR_ROWS { bf16_t* rp = O + (size_t)EPI_ROW * ldc; EPI_FOR_BJ { f32x4 v0 = acc[ai][bj][m][0], v1 = acc[ai][bj][m][1];
#pragma unroll
            for (int j = 0; j < 4; ++j) { const float r0 = fmaxf(v0[j], 0.f), r1 = fmaxf(v1[j], 0.f); v0[j] = r0 * r0; v1[j] = r1 * r1; }
            st_bf8(rp + EPI_COL8, v0, v1); } }
    }
    __device__ __forceinline__ void khook(AccT&, const Unit&, int, int, int, int, int) const {}
};
struct EpiSigmoid {
    static constexpr bool KHOOK = false, PERM = true;
    bf16_t* O; int ldc; const float* bias;
    __device__ __forceinline__ void operator()(const AccT& acc, const Unit& u, int wr, int wc, int fr, int fq) const {
        f32x4 bv[2][2];
        EPI_FOR_BJ { const int c = EPI_COL8; bv[bj][0] = *(const f32x4*)(bias + c); bv[bj][1] = *(const f32x4*)(bias + c + 4); }
        EPI_FOR_ROWS { bf16_t* rp = O + (size_t)EPI_ROW * ldc; EPI_FOR_BJ { f32x4 v0 = acc[ai][bj][m][0] + bv[bj][0], v1 = acc[ai][bj][m][1] + bv[bj][1];
#pragma unroll
            for (int j = 0; j < 4; ++j) { v0[j] = sigmoidf_(v0[j]); v1[j] = sigmoidf_(v1[j]); }
            st_bf8(rp + EPI_COL8, v0, v1); } }
    }
    __device__ __forceinline__ void khook(AccT&, const Unit&, int, int, int, int, int) const {}
};
struct EpiGlu {
    static constexpr bool KHOOK = false, PERM = true;
    bf16_t* O; int ldc; int ocol0; const bf16_t* Yin; int ldy; const float* bias;
    __device__ __forceinline__ void operator()(const AccT& acc, const Unit& u, int wr, int wc, int fr, int fq) const {
#pragma unroll
        for (int ai = 0; ai < 2; ++ai) {
            u32x4 yq[4][2];
#pragma unroll
            for (int m = 0; m < 4; ++m) { const size_t row = (size_t)EPI_ROW; EPI_FOR_BJ yq[m][bj] = *(const u32x4*)(Yin + row * ldy + EPI_COL8); }
            __builtin_amdgcn_sched_barrier(0);
#pragma unroll
            for (int m = 0; m < 4; ++m) { const size_t row = (size_t)EPI_ROW; EPI_FOR_BJ { const int c = EPI_COL8; const u32x4 w = yq[m][bj]; const f32x4 y0 = bf4lo(w), y1 = bf4hi(w);
                f32x4 v0 = acc[ai][bj][m][0] + *(const f32x4*)(bias + c), v1 = acc[ai][bj][m][1] + *(const f32x4*)(bias + c + 4);
#pragma unroll
                for (int j = 0; j < 4; ++j) { v0[j] = y0[j] * sigmoidf_(v0[j]); v1[j] = y1[j] * sigmoidf_(v1[j]); }
                st_bf8(O + row * ldc + ocol0 + c, v0, v1); } }
            __builtin_amdgcn_sched_barrier(0);
        }
    }
    __device__ __forceinline__ void khook(AccT&, const Unit&, int, int, int, int, int) const {}
};
struct EpiMerge {
    static constexpr bool KHOOK = true, PERM = true;
    bf16_t* O; const bf16_t* G;
    __device__ __forceinline__ void khook(AccT& acc, const Unit& u, int t, int wr, int wc, int fr, int fq) const {
        unsigned goff = (unsigned)((u.pm * 256 + wr * 64 + fr) * 3072 + u.pn * 256 + wc * 32 + 8 * fq + ((t == 8) ? 0 : 1024)) * 2u;
        asm volatile("" : "+v"(goff));
        const char* gb = (const char*)G;
#pragma unroll
        for (int ai = 0; ai < 2; ++ai) {
            u32x4 q0[4][2], q1[4][2];
#pragma unroll
            for (int m = 0; m < 4; ++m) EPI_FOR_BJ { const unsigned o = goff + (unsigned)(((ai * 128 + m * 16) * 3072 + bj * 128) * 2);
                q0[m][bj] = *(const u32x4*)(gb + o); q1[m][bj] = *(const u32x4*)(gb + o + 2048); }
            __builtin_amdgcn_sched_barrier(0);
#pragma unroll
            for (int m = 0; m < 4; ++m) EPI_FOR_BJ { const u32x4 a = q0[m][bj], b = q1[m][bj];
                const f32x4 g00 = bf4lo(a), g01 = bf4hi(a), g10 = bf4lo(b), g11 = bf4hi(b);
#pragma unroll
                for (int j = 0; j < 4; ++j) { acc[ai][bj][m][0][j] *= g00[j] * __builtin_amdgcn_rcpf(g10[j]); acc[ai][bj][m][1][j] *= g01[j] * __builtin_amdgcn_rcpf(g11[j]); } }
            __builtin_amdgcn_sched_barrier(0);
        }
    }
    __device__ __forceinline__ void operator()(const AccT& acc, const Unit& u, int wr, int wc, int fr, int fq) const {
        u32x4 gq[2][4][2];
        EPI_FOR_ROWS { const size_t row = (size_t)EPI_ROW; EPI_FOR_BJ gq[ai][m][bj] = *(const u32x4*)(G + row * 3072 + 2048 + EPI_COL8); }
        __builtin_amdgcn_sched_barrier(0);
        EPI_FOR_ROWS { const size_t row = (size_t)EPI_ROW; EPI_FOR_BJ { const u32x4 w = gq[ai][m][bj];
            st_bf8(O + row * 1024 + EPI_COL8, acc[ai][bj][m][0] * bf4lo(w), acc[ai][bj][m][1] * bf4hi(w)); } }
    }
};
struct EpiResid {
    static constexpr bool KHOOK = false, PERM = true;
    bf16_t* C; const bf16_t* X;
    __device__ __forceinline__ void operator()(const AccT& acc, const Unit& u, int wr, int wc, int fr, int fq) const {
        u32x4 xq[2][4][2];
        EPI_FOR_ROWS { const size_t row = (size_t)EPI_ROW; EPI_FOR_BJ xq[ai][m][bj] = *(const u32x4*)(X + row * 1024 + EPI_COL8); }
        __builtin_amdgcn_sched_barrier(0);
        EPI_FOR_ROWS { const size_t row = (size_t)EPI_ROW; EPI_FOR_BJ { const u32x4 w = xq[ai][m][bj];
            st_bf8(C + row * 1024 + EPI_COL8, bf4lo(w) * DN_ALPHA + acc[ai][bj][m][0], bf4hi(w) * DN_ALPHA + acc[ai][bj][m][1]); } }
    }
    __device__ __forceinline__ void khook(AccT&, const Unit&, int, int, int, int, int) const {}
};

template <class Epi>
__device__ __forceinline__ void run_gemm(const int tid, const int bid, const int gsz, unsigned char* smem, const bf16_t* A, int lda, const bf16_t* Bt, int ldb, int N, int K, const Epi& E) {
    pg8::Gemm g; g.A = A; g.Bt = Bt; g.M = T_; g.N = N; g.K = K; g.lda = lda; g.ldb = ldb;
    pg8::StaticOrder S; S.init(T_, N, gsz, bid);
    pg8::gemm_phase<Epi>((LAS unsigned char*)smem, g, S, E, tid);
}

__device__ __forceinline__ void transpose_cvt(const int tid, const int bid, const int gsz, const float* __restrict__ src, int K, int N, bf16_t* __restrict__ dst, float* tile) {
    const int tn = N / 64, ntile = (K / 64) * tn;
    for (int t = bid; t < ntile; t += gsz) {
        const int k0 = (t / tn) * 64, n0 = (t % tn) * 64;
#pragma unroll
        for (int r = 0; r < 2; ++r) { const int i = (tid >> 4) + 32 * r, j = (tid & 15) * 4;
            const f32x4 v = *(const f32x4*)(src + (size_t)(k0 + i) * N + n0 + j);
            tile[i * 65 + j] = v[0]; tile[i * 65 + j + 1] = v[1]; tile[i * 65 + j + 2] = v[2]; tile[i * 65 + j + 3] = v[3]; }
        __syncthreads();
        const int jn = tid >> 3, i8 = (tid & 7) * 8;
        u32x4 w;
        w.x = pk2(tile[(i8 + 0) * 65 + jn], tile[(i8 + 1) * 65 + jn]); w.y = pk2(tile[(i8 + 2) * 65 + jn], tile[(i8 + 3) * 65 + jn]);
        w.z = pk2(tile[(i8 + 4) * 65 + jn], tile[(i8 + 5) * 65 + jn]); w.w = pk2(tile[(i8 + 6) * 65 + jn], tile[(i8 + 7) * 65 + jn]);
        *(u32x4*)(dst + (size_t)(n0 + jn) * K + k0 + i8) = w;
        __syncthreads();
    }
}
__device__ __forceinline__ void phase_convert(const int tid, const int bid, const int gsz, const Params& p, int l, unsigned char* smem) {
    float* tile = (float*)smem;
    bf16_t* W = (bf16_t*)(p.ws + W_OFF + (size_t)l * 40 * MiB);
    transpose_cvt(tid, bid, gsz, p.w_in + (size_t)l * 1024 * PTOT, 1024, PTOT, W + WT_IN, tile);
    transpose_cvt(tid, bid, gsz, p.c_w_glu + (size_t)l * 512 * 512, 512, 512, W + WT_GLU, tile);
    transpose_cvt(tid, bid, gsz, p.w_branch + (size_t)l * 2048 * 1024, 2048, 1024, W + WT_BR, tile);
    transpose_cvt(tid, bid, gsz, p.w_out + (size_t)l * 1024 * 1024, 1024, 1024, W + WT_OUT, tile);
    transpose_cvt(tid, bid, gsz, p.w_ff1 + (size_t)l * 1024 * 4096, 1024, 4096, W + WT_FF1, tile);
    transpose_cvt(tid, bid, gsz, p.w_ff2 + (size_t)l * 4096 * 1024, 4096, 1024, W + WT_FF2, tile);
    if (l == 0) {
        bf16_t* X = (bf16_t*)(p.ws + XBF_OFF);
        const size_t n4 = (size_t)T_ * D_ / 4;
        for (size_t i = (size_t)bid * 512 + tid; i < n4; i += (size_t)gsz * 512) {
            const f32x4 v = *(const f32x4*)(p.x + i * 4); st_bf4(X + i * 4, v); }
    }
}

__device__ __forceinline__ void phase_ln(const int tid, const int bid, const int gsz, const bf16_t* src, const float* gam, const float* bet, bf16_t* xbf, float* fout) {
    const int lane = tid & 63, wid = tid >> 6;
    f32x4 gv[4], bv[4];
#pragma unroll
    for (int j = 0; j < 4; ++j) { gv[j] = *(const f32x4*)(gam + lane * 4 + 256 * j); bv[j] = *(const f32x4*)(bet + lane * 4 + 256 * j); }
    for (int row = bid * 8 + wid; row < T_; row += gsz * 8) {
        const bf16_t* rp = src + (size_t)row * D_;
        f32x4 v[4]; float s = 0.f;
#pragma unroll
        for (int j = 0; j < 4; ++j) { v[j] = ld_bf4(rp + lane * 4 + 256 * j); s += (v[j][0] + v[j][1]) + (v[j][2] + v[j][3]); }
        const float mean = wave_sum(s) * (1.f / D_); float s2 = 0.f;
#pragma unroll
        for (int j = 0; j < 4; ++j) { v[j] = v[j] - mean; s2 += (v[j][0] * v[j][0] + v[j][1] * v[j][1]) + (v[j][2] * v[j][2] + v[j][3] * v[j][3]); }
        const float rstd = rsqrtf(wave_sum(s2) * (1.f / D_) + 1e-5f);
#pragma unroll
        for (int j = 0; j < 4; ++j) { const f32x4 o = v[j] * rstd * gv[j] + bv[j];
            st_bf4(xbf + (size_t)row * D_ + lane * 4 + 256 * j, o);
            if (fout) *(f32x4*)(fout + (size_t)row * D_ + lane * 4 + 256 * j) = o; }
    }
}

__device__ __forceinline__ int rwkv_gcol(int vi, int h) { return (vi < 24) ? ((vi >> 3) * 512 + h * 64 + (vi & 7) * 8) : (1536 + (vi - 24) * 8); }
__device__ __forceinline__ void prep_bar(unsigned* cnt, unsigned& gen, int lane) {
    gen += 4u;
    asm volatile("s_waitcnt lgkmcnt(0)" ::: "memory");
    if (lane == 0) __hip_atomic_fetch_add(cnt, 1u, __ATOMIC_RELAXED, __HIP_MEMORY_SCOPE_WORKGROUP);
    while (__hip_atomic_load(cnt, __ATOMIC_RELAXED, __HIP_MEMORY_SCOPE_WORKGROUP) < gen) __builtin_amdgcn_s_sleep(1);
    asm volatile("" ::: "memory");
}
__device__ __forceinline__ void rwkv_item(const int tid, const Params& p, int l, int b, int h, unsigned char* smem) {
    const int lane = tid & 63, wid = tid >> 6, quad = lane >> 4, l15 = lane & 15;
    float* R2 = (float*)smem; float* K2 = R2 + 4096; float* V2 = K2 + 4096; float* W2 = V2 + 4096; float* NA2 = W2 + 4096; float* NB2 = NA2 + 4096;
    float* G2 = NB2 + 4096; float* O2 = G2 + 4096; float* A_ = O2 + 4096; float* RK2 = A_ + 2048;
    bf16_t* ZL = (bf16_t*)(RK2 + 64);
    float* MU = (float*)(ZL + 32 * 264);
    unsigned* SBAR = (unsigned*)(MU + 448);
    const bf16_t* P = (const bf16_t*)(p.ws + P_OFF) + (size_t)b * S_ * PW;
    bf16_t* Y = (bf16_t*)p.out + (size_t)b * S_ * 2048;
    for (int c = tid; c < 448; c += 512) { const int vi = c >> 3; MU[c] = p.a_shift[l * 1792 + rwkv_gcol(vi, h) + (c & 7)]; }
    if (tid == 0) SBAR[0] = 0u;
    __syncthreads();
    if (tid < 256) {
        const int sv = (tid >> 3) & 31, sj = tid & 7;
        f32x2 SA[4], SB[4];
#pragma unroll
        for (int i = 0; i < 4; ++i) { SA[i] = (f32x2){0.f, 0.f}; SB[i] = SA[i]; }
        __syncthreads();
        for (int ch = 0; ch < S_ / 32; ++ch) {
            const int cb = (ch & 1) * 2048;
            const float* Rc = R2 + cb; const float* Kc = K2 + cb; const float* Vc = V2 + cb; const float* Wc = W2 + cb; const float* NAc = NA2 + cb; const float* NBc = NB2 + cb;
            float* Oc = O2 + cb;
            f32x4 cna0, cna1, cw0, cw1, cnb0, cnb1, ckt0, ckt1, cr0, cr1; float cva, cvb;
#define RW_LOAD(tt_) do { const int o_ = (tt_) * 64 + sj * 8; \
            cna0 = *(const f32x4*)(NAc + o_); cna1 = *(const f32x4*)(NAc + o_ + 4); cw0 = *(const f32x4*)(Wc + o_); cw1 = *(const f32x4*)(Wc + o_ + 4); \
            cnb0 = *(const f32x4*)(NBc + o_); cnb1 = *(const f32x4*)(NBc + o_ + 4); ckt0 = *(const f32x4*)(Kc + o_); ckt1 = *(const f32x4*)(Kc + o_ + 4); \
            cr0 = *(const f32x4*)(Rc + o_); cr1 = *(const f32x4*)(Rc + o_ + 4); cva = Vc[(tt_) * 64 + sv]; cvb = Vc[(tt_) * 64 + sv + 32]; } while (0)
            RW_LOAD(0);
#pragma unroll 32
            for (int tt = 0; tt < 32; ++tt) {
                const f32x4 na0 = cna0, na1 = cna1, w0 = cw0, w1 = cw1, nb0 = cnb0, nb1 = cnb1, kt0 = ckt0, kt1 = ckt1, r0 = cr0, r1 = cr1; const float va = cva, vb = cvb;
                { const int tn = (tt + 1) & 31; RW_LOAD(tn); }
                const f32x2 n0 = {na0[0], na0[1]}, n1 = {na0[2], na0[3]}, n2 = {na1[0], na1[1]}, n3 = {na1[2], na1[3]};
                f32x2 pa = SA[0] * n0; pa = SA[1] * n1 + pa; pa = SA[2] * n2 + pa; pa = SA[3] * n3 + pa;
                f32x2 pb = SB[0] * n0; pb = SB[1] * n1 + pb; pb = SB[2] * n2 + pb; pb = SB[3] * n3 + pb;
                float sa = pa[0] + pa[1], sb = pb[0] + pb[1];
                sa = sum8(sa); sb = sum8(sb);
                const f32x2 wv[4] = {{w0[0], w0[1]}, {w0[2], w0[3]}, {w1[0], w1[1]}, {w1[2], w1[3]}};
                const f32x2 nbv[4] = {{nb0[0], nb0[1]}, {nb0[2], nb0[3]}, {nb1[0], nb1[1]}, {nb1[2], nb1[3]}};
                const f32x2 ktv[4] = {{kt0[0], kt0[1]}, {kt0[2], kt0[3]}, {kt1[0], kt1[1]}, {kt1[2], kt1[3]}};
#pragma unroll
                for (int i = 0; i < 4; ++i) { SA[i] = SA[i] * wv[i] + (nbv[i] * sa + ktv[i] * va); SB[i] = SB[i] * wv[i] + (nbv[i] * sb + ktv[i] * vb); }
                const f32x2 q0 = {r0[0], r0[1]}, q1 = {r0[2], r0[3]}, q2 = {r1[0], r1[1]}, q3 = {r1[2], r1[3]};
                f32x2 oa = SA[0] * q0; oa = SA[1] * q1 + oa; oa = SA[2] * q2 + oa; oa = SA[3] * q3 + oa;
                f32x2 ob = SB[0] * q0; ob = SB[1] * q1 + ob; ob = SB[2] * q2 + ob; ob = SB[3] * q3 + ob;
                float xa = oa[0] + oa[1], xb = ob[0] + ob[1];
                xa = sum8(xa); xb = sum8(xb);
                if (sj == 0) { Oc[tt * 64 + sv] = xa; Oc[tt * 64 + sv + 32] = xb; }
            }
#undef RW_LOAD
            __syncthreads();
        }
        __syncthreads();
    } else {
        const int st = tid - 256, pw = wid - 4;
        const int ocol = h * 64 + pw * 16 + l15;
        bf16x8 Bw[2], Ba[2], Bg[4];
#pragma unroll
        for (int ks = 0; ks < 2; ++ks)
#pragma unroll
            for (int jj = 0; jj < 8; ++jj) { const int k = ks * 32 + quad * 8 + jj;
                Bw[ks][jj] = (short)f2bf(p.a_w2[((size_t)l * 64 + k) * 512 + ocol]); Ba[ks][jj] = (short)f2bf(p.a_a2[((size_t)l * 64 + k) * 512 + ocol]); }
#pragma unroll
        for (int ks = 0; ks < 4; ++ks)
#pragma unroll
            for (int jj = 0; jj < 8; ++jj) { const int k = ks * 32 + quad * 8 + jj; Bg[ks][jj] = (short)f2bf(p.a_g2[((size_t)l * 128 + k) * 512 + ocol]); }
        const float w0v = p.a_w0[l * 512 + ocol], a0v = p.a_a0[l * 512 + ocol];
        const int ett0 = st >> 4, ecg = st & 15;
        const int hc = l * 512 + h * 64 + ecg * 4;
        const f32x4 kkc = *(const f32x4*)(p.a_kk + hc), kac = *(const f32x4*)(p.a_ka + hc), rkc = *(const f32x4*)(p.a_rk + hc),
                    lng = *(const f32x4*)(p.a_lnx_g + hc), lnb = *(const f32x4*)(p.a_lnx_b + hc);
        int svi, srg;
        if (st < 128) { srg = st >> 5; const int j = st & 31; svi = (j < 24) ? j : (8 + j); }
        else { const int u = st - 128; srg = u / 24; const int j = u - srg * 24; svi = (j < 8) ? (24 + j) : (32 + j); }
        const bool shact = st < 224;
        const float tr_a = (svi < 32) ? 2.0f : 1.0f, tr_b = (svi < 32) ? 2.8853900817779268f : 1.4426950408889634f, tr_c = (svi < 32) ? -1.0f : 0.0f;
        const bf16_t* sptr = P + (size_t)(srg * 8 - 1) * PW + rwkv_gcol(svi, h);
        u32x4 pr[9];
        unsigned gen = 0u;
#define RW_PREFETCH(t0n_) do { if (shact) { _Pragma("unroll") for (int j = 0; j < 9; ++j) { \
        pr[j] = ((t0n_) + srg * 8 - 1 + j >= 0) ? *(const u32x4*)(sptr + (size_t)((t0n_) + j) * PW) : (u32x4){0u, 0u, 0u, 0u}; } } } while (0)
#define RW_SHIFT(nb_) do { if (shact) { float* Rn_ = R2 + (nb_); float* Kn_ = K2 + (nb_); float* Vn_ = V2 + (nb_); const int vi = svi; \
        const f32x4 m0 = *(const f32x4*)(MU + vi * 8), m1 = *(const f32x4*)(MU + vi * 8 + 4); \
        _Pragma("unroll") for (int j = 1; j < 9; ++j) { const int tt = srg * 8 + j - 1; const u32x4 cw = pr[j], pw_ = pr[j - 1]; f32x4 z0, z1; \
            { const f32x4 c0 = {bflo(cw.x), bfhi(cw.x), bflo(cw.y), bfhi(cw.y)}, c1 = {bflo(cw.z), bfhi(cw.z), bflo(cw.w), bfhi(cw.w)}; \
              const f32x4 p0 = {bflo(pw_.x), bfhi(pw_.x), bflo(pw_.y), bfhi(pw_.y)}, p1 = {bflo(pw_.z), bfhi(pw_.z), bflo(pw_.w), bfhi(pw_.w)}; \
              z0 = c0 + m0 * (p0 - c0); z1 = c1 + m1 * (p1 - c1); } \
            if (vi < 24) { float* dst = ((vi < 8) ? Rn_ : (vi < 16) ? Kn_ : Vn_) + tt * 64 + (vi & 7) * 8; *(f32x4*)dst = z0; *(f32x4*)(dst + 4) = z1; } \
            else { if (st >= 128) { _Pragma("unroll") for (int q = 0; q < 4; ++q) { \
                       z0[q] = tr_a * __builtin_amdgcn_rcpf(1.0f + __builtin_amdgcn_exp2f(-tr_b * z0[q])) + tr_c; z1[q] = tr_a * __builtin_amdgcn_rcpf(1.0f + __builtin_amdgcn_exp2f(-tr_b * z1[q])) + tr_c; } } \
                   u32x4 o; o.x = pk2(z0[0], z0[1]); o.y = pk2(z0[2], z0[3]); o.z = pk2(z1[0], z1[1]); o.w = pk2(z1[2], z1[3]); \
                   *(u32x4*)(ZL + tt * 264 + (vi - 24) * 8) = o; } } } } while (0)
#define RW_LORA(nb_) do { _Pragma("unroll") for (int rt = 0; rt < 2; ++rt) { f32x4 cw = {0.f, 0.f, 0.f, 0.f}, ca = cw, cgv = cw; const bf16_t* zrow = ZL + (rt * 16 + l15) * 264 + quad * 8; \
        _Pragma("unroll") for (int ks = 0; ks < 2; ++ks) { const bf16x8 a = *(const bf16x8*)(zrow + ks * 32); cw = MFMA16(a, Bw[ks], cw); } \
        _Pragma("unroll") for (int ks = 0; ks < 2; ++ks) { const bf16x8 a = *(const bf16x8*)(zrow + 64 + ks * 32); ca = MFMA16(a, Ba[ks], ca); } \
        _Pragma("unroll") for (int ks = 0; ks < 4; ++ks) { const bf16x8 a = *(const bf16x8*)(zrow + 128 + ks * 32); cgv = MFMA16(a, Bg[ks], cgv); } \
        _Pragma("unroll") for (int jj = 0; jj < 4; ++jj) { const int tt = rt * 16 + quad * 4 + jj, col = pw * 16 + l15; \
            W2[(nb_) + tt * 64 + col] = __builtin_amdgcn_exp2f(-0.8750387749860377f * sigmoidf_(cw[jj] + w0v)); \
            A_[tt * 64 + col] = sigmoidf_(ca[jj] + a0v); G2[(nb_) + tt * 64 + col] = cgv[jj]; } } } while (0)
#define RW_ELEM(nb_) do { _Pragma("unroll") for (int it = 0; it < 2; ++it) { const int ett = ett0 + 16 * it; const int o = ett * 64 + ecg * 4; float* Kn_ = K2 + (nb_); \
        const f32x4 k4 = *(const f32x4*)(Kn_ + o), a4 = *(const f32x4*)(A_ + o), r4 = *(const f32x4*)(R2 + (nb_) + o); \
        const f32x4 kk = k4 * kkc; float ss = (kk[0] * kk[0] + kk[1] * kk[1]) + (kk[2] * kk[2] + kk[3] * kk[3]); ss = sum16(ss); \
        const float inv = __builtin_amdgcn_rsqf(fmaxf(ss, 1e-24f)); const f32x4 kkn = kk * inv; \
        *(f32x4*)(NA2 + (nb_) + o) = -kkn; *(f32x4*)(NB2 + (nb_) + o) = kkn * a4; \
        const f32x4 kt = k4 * (1.0f + (a4 - 1.0f) * kac); *(f32x4*)(Kn_ + o) = kt; \
        const f32x4 pr_ = r4 * kt * rkc; float rk = (pr_[0] + pr_[1]) + (pr_[2] + pr_[3]); rk = sum16(rk); \
        if (ecg == 0) RK2[((nb_) >> 6) + ett] = rk; } } while (0)
#define RW_OUT(cb_, t0_) do { _Pragma("unroll") for (int it = 0; it < 2; ++it) { const int ett = ett0 + 16 * it; const int o = ett * 64 + ecg * 4; \
        const f32x4 o4 = *(const f32x4*)(O2 + (cb_) + o); float s = (o4[0] + o4[1]) + (o4[2] + o4[3]); s = sum16(s); \
        const float mean = s * (1.f / 64.f); const f32x4 d = o4 - mean; \
        float q = (d[0] * d[0] + d[1] * d[1]) + (d[2] * d[2] + d[3] * d[3]); q = sum16(q); \
        const float rstd = rsqrtf(q * (1.f / 64.f) + 64e-5f); \
        const f32x4 v4 = *(const f32x4*)(V2 + (cb_) + o), g4 = *(const f32x4*)(G2 + (cb_) + o); const float rk = RK2[((cb_) >> 6) + ett]; \
        const f32x4 y = ((d * rstd) * lng + lnb + v4 * rk) * g4; \
        st_bf4(Y + (size_t)((t0_) + ett) * 2048 + h * 64 + ecg * 4, y); } } while (0)
        RW_PREFETCH(0);
        RW_SHIFT(0); RW_PREFETCH(32);
        prep_bar(SBAR, gen, lane);
        RW_LORA(0);
        prep_bar(SBAR, gen, lane);
        RW_ELEM(0);
        __syncthreads();
        for (int ch = 0; ch < S_ / 32; ++ch) {
            const int nb = ((ch + 1) & 1) * 2048;
            if (ch >= 1) RW_OUT(nb, (ch - 1) * 32);
            if (ch + 1 < S_ / 32) {
                prep_bar(SBAR, gen, lane);
                RW_SHIFT(nb);
                if (ch + 2 < S_ / 32) RW_PREFETCH((ch + 2) * 32);
                prep_bar(SBAR, gen, lane);
                RW_LORA(nb);
                prep_bar(SBAR, gen, lane);
                RW_ELEM(nb);
            }
            __syncthreads();
        }
        RW_OUT(2048, (S_ / 32 - 1) * 32);
        __syncthreads();
#undef RW_PREFETCH
#undef RW_SHIFT
#undef RW_LORA
#undef RW_ELEM
#undef RW_OUT
    }
}

__device__ __forceinline__ void ret_item(const int tid, const Params& p, int l, int b, int h, unsigned char* smem) {
    const int lane = tid & 63, wid = tid >> 6, quad = lane >> 4, l15 = lane & 15;
    bf16_t* Qs = (bf16_t*)smem;
    bf16_t* Ks = Qs + 32 * 136;
    bf16_t* Kt = Ks + 32 * 136;
    bf16_t* Vt = Kt + 128 * 40;
    bf16_t* Ss = Vt + 256 * 40;
    bf16_t* Rt = Ss + 32 * 40;
    float* Sp = (float*)(Rt + 256 * 136);
    float* Sf = Sp + 512;
    const bf16_t* P = (const bf16_t*)(p.ws + P_OFF) + (size_t)b * S_ * PW;
    bf16_t* Y = (bf16_t*)p.out + (size_t)b * S_ * 2048;
    const float lg2 = log2f(1.0f - exp2f(-5.0f - (float)h));
    const float gC = exp2f(lg2 * 32.f);
    for (int i = tid; i < 256 * 136 / 2; i += 512) ((unsigned*)Rt)[i] = 0u;
    f32x4 accR[8][2];
#pragma unroll
    for (int dt = 0; dt < 8; ++dt) { accR[dt][0] = (f32x4){0.f, 0.f, 0.f, 0.f}; accR[dt][1] = accR[dt][0]; }
    const int ltt = tid >> 4, dg = tid & 15;
    float cfr[4];
#pragma unroll
    for (int q = 0; q < 4; ++q) cfr[q] = exp2f(-(float)(dg + 16 * q) * (13.287712379549449f / 64.f)) * 0.15915494309189535f;
    const float decK = exp2f(lg2 * (float)(31 - ltt));
    const bf16_t* lrow = P + (size_t)ltt * PW + h * 128 + dg;
    const bf16_t* vrow = P + (size_t)ltt * PW + 2816 + h * 256 + dg;
    bf16_t pq1[4], pq2[4], pk1[4], pk2_[4], pv[16], pg[2][4][2];
    const bf16_t* grow = P + 3840 + h * 256 + wid * 32 + l15;
#pragma unroll
    for (int q = 0; q < 4; ++q) { pq1[q] = lrow[1792 + 16 * q]; pq2[q] = lrow[1792 + 64 + 16 * q]; pk1[q] = lrow[2304 + 16 * q]; pk2_[q] = lrow[2304 + 64 + 16 * q]; }
#pragma unroll
    for (int c = 0; c < 16; ++c) pv[c] = vrow[16 * c];
    __syncthreads();
    for (int ch = 0; ch < S_ / 32; ++ch) {
#pragma unroll
        for (int rt = 0; rt < 2; ++rt)
#pragma unroll
            for (int jj = 0; jj < 4; ++jj)
#pragma unroll
                for (int ct = 0; ct < 2; ++ct) pg[rt][jj][ct] = grow[(size_t)(ch * 32 + rt * 16 + quad * 4 + jj) * PW + ct * 16];

        const int t0 = ch * 32;
        {
            const int t = t0 + ltt;
#pragma unroll
            for (int q = 0; q < 4; ++q) {
                float rev = (float)t * cfr[q]; rev -= floorf(rev);
                const float cs = __builtin_amdgcn_cosf(rev), sn = __builtin_amdgcn_sinf(rev);
                const float q1 = bf2f(pq1[q]), q2 = bf2f(pq2[q]), k1 = bf2f(pk1[q]), k2 = bf2f(pk2_[q]);
                const float qa = q1 * cs - q2 * sn, qb = q2 * cs + q1 * sn;
                const float ka = (k1 * cs - k2 * sn) * 0.08838834764831845f, kb = (k2 * cs + k1 * sn) * 0.08838834764831845f;
                const int d = dg + 16 * q;
                Qs[ltt * 136 + d] = f2bf(qa); Qs[ltt * 136 + 64 + d] = f2bf(qb);
                Ks[ltt * 136 + d] = f2bf(ka); Ks[ltt * 136 + 64 + d] = f2bf(kb);
                Kt[d * 40 + ltt] = f2bf(ka * decK); Kt[(64 + d) * 40 + ltt] = f2bf(kb * decK);
            }
#pragma unroll
            for (int c = 0; c < 16; ++c) Vt[(dg + 16 * c) * 40 + ltt] = pv[c];
        }
        __syncthreads();
        if (ch + 1 < S_ / 32) {
            const size_t adv = (size_t)(t0 + 32) * PW;
#pragma unroll
            for (int q = 0; q < 4; ++q) { pq1[q] = lrow[adv + 1792 + 16 * q]; pq2[q] = lrow[adv + 1792 + 64 + 16 * q]; pk1[q] = lrow[adv + 2304 + 16 * q]; pk2_[q] = lrow[adv + 2304 + 64 + 16 * q]; }
#pragma unroll
            for (int c = 0; c < 16; ++c) pv[c] = vrow[adv + 16 * c];
        }
        if (wid < 4) {
            const int ri = wid & 1, cj = wid >> 1;
            f32x4 sc = {0.f, 0.f, 0.f, 0.f};
#pragma unroll
            for (int ks = 0; ks < 4; ++ks) { const bf16x8 a = *(const bf16x8*)(Qs + (ri * 16 + l15) * 136 + ks * 32 + quad * 8); const bf16x8 bb = *(const bf16x8*)(Ks + (cj * 16 + l15) * 136 + ks * 32 + quad * 8);
                sc = MFMA16(a, bb, sc); }
#pragma unroll
            for (int jj = 0; jj < 4; ++jj) { const int i = ri * 16 + quad * 4 + jj, j = cj * 16 + l15; const int rel = i - j;
                const float val = (rel >= 0) ? sc[jj] * exp2f(lg2 * (float)rel) : 0.f;
                Ss[i * 40 + j] = f2bf(val); }
        }
        f32x4 ao[2][2];
        ao[0][0] = (f32x4){0.f, 0.f, 0.f, 0.f}; ao[0][1] = ao[0][0]; ao[1][0] = ao[0][0]; ao[1][1] = ao[0][0];
#pragma unroll
        for (int ks = 0; ks < 4; ++ks) {
            const bf16x8 a0 = *(const bf16x8*)(Qs + l15 * 136 + ks * 32 + quad * 8), a1 = *(const bf16x8*)(Qs + (16 + l15) * 136 + ks * 32 + quad * 8);
#pragma unroll
            for (int ct = 0; ct < 2; ++ct) { const bf16x8 bb = *(const bf16x8*)(Rt + (wid * 32 + ct * 16 + l15) * 136 + ks * 32 + quad * 8);
                ao[0][ct] = MFMA16(a0, bb, ao[0][ct]); ao[1][ct] = MFMA16(a1, bb, ao[1][ct]); }
        }
#pragma unroll
        for (int rt = 0; rt < 2; ++rt)
#pragma unroll
            for (int jj = 0; jj < 4; ++jj) { const float s = exp2f(lg2 * (float)(rt * 16 + quad * 4 + jj + 1)); ao[rt][0][jj] *= s; ao[rt][1][jj] *= s; }
        __syncthreads();
        {
            bf16x8 bv[2];
#pragma unroll
            for (int ct = 0; ct < 2; ++ct) bv[ct] = *(const bf16x8*)(Vt + (wid * 32 + ct * 16 + l15) * 40 + quad * 8);
#pragma unroll
            for (int rt = 0; rt < 2; ++rt) { const bf16x8 a = *(const bf16x8*)(Ss + (rt * 16 + l15) * 40 + quad * 8);
                ao[rt][0] = MFMA16(a, bv[0], ao[rt][0]); ao[rt][1] = MFMA16(a, bv[1], ao[rt][1]); }
#pragma unroll
            for (int dt = 0; dt < 8; ++dt) { const bf16x8 a = *(const bf16x8*)(Kt + (dt * 16 + l15) * 40 + quad * 8);
#pragma unroll
                for (int ct = 0; ct < 2; ++ct) { accR[dt][ct] = accR[dt][ct] * gC; accR[dt][ct] = MFMA16(a, bv[ct], accR[dt][ct]);
                    st_bf4(Rt + (wid * 32 + ct * 16 + l15) * 136 + dt * 16 + quad * 4, accR[dt][ct]); } }
        }
#pragma unroll
        for (int rt = 0; rt < 2; ++rt)
#pragma unroll
            for (int jj = 0; jj < 4; ++jj) { const float x0 = ao[rt][0][jj], x1 = ao[rt][1][jj];
                float s = x0 + x1, ss = x0 * x0 + x1 * x1; s = sum16(s); ss = sum16(ss);
                if (l15 == 0) { const int i = rt * 16 + quad * 4 + jj; Sp[(i * 8 + wid) * 2] = s; Sp[(i * 8 + wid) * 2 + 1] = ss; } }
        __syncthreads();
        if (tid < 32) { float s = 0.f, ss = 0.f;
#pragma unroll
            for (int w = 0; w < 8; ++w) { s += Sp[(tid * 8 + w) * 2]; ss += Sp[(tid * 8 + w) * 2 + 1]; }
            const float mean = s * (1.f / 256.f); const float var = fmaxf(ss * (1.f / 256.f) - mean * mean, 0.f);
            Sf[tid * 2] = mean; Sf[tid * 2 + 1] = rsqrtf(var + 1e-5f); }
        __syncthreads();
#pragma unroll
        for (int rt = 0; rt < 2; ++rt)
#pragma unroll
            for (int jj = 0; jj < 4; ++jj) { const int i = rt * 16 + quad * 4 + jj; const float mean = Sf[i * 2], rstd = Sf[i * 2 + 1]; const size_t t = (size_t)(t0 + i);
#pragma unroll
                for (int ct = 0; ct < 2; ++ct) { const int e = wid * 32 + ct * 16 + l15;
                    const float g = bf2f(pg[rt][jj][ct]);
                    const float y = g * sigmoidf_(g) * ((ao[rt][ct][jj] - mean) * rstd);
                    Y[t * 2048 + 512 + h * 256 + e] = f2bf(y); } }
    }
}

__device__ __forceinline__ void s5_wave(const int tid, const Params& p, int l, int b, int g, unsigned char* wsm) {
    const int lane = tid & 63, quad = lane >> 4, l15 = lane & 15;
    float* U = (float*)wsm;
    bf16_t* X = (bf16_t*)(wsm + 2048);
    const bf16_t* P = (const bf16_t*)(p.ws + P_OFF) + (size_t)b * S_ * PW + 4864 + g * 16;
    bf16_t* Cp = (bf16_t*)(p.ws + CPRE_OFF) + (size_t)b * S_ * 512 + g * 16;
    const int lg = l * 32 + g;
    const float dt = expf(p.c_log_dt[lg]);
    const float lr = p.c_lam_re[lg * 64 + lane], li = p.c_lam_im[lg * 64 + lane];
    const float em1 = expm1f(lr * dt);
    const float th = li * dt;
    const float cth = cosf(th), sth = sinf(th), sh = sinf(0.5f * th);
    const float abr = (em1 + 1.0f) * cth, abi = (em1 + 1.0f) * sth;
    const float abr_m1 = em1 * cth - 2.0f * sh * sh;
    const float den = lr * lr + li * li;
    const float fre = (abr_m1 * lr + abi * li) / den, fim = (abi * lr - abr_m1 * li) / den;
    f32x2 bbr[8], bbi[8];
#pragma unroll
    for (int c4 = 0; c4 < 4; ++c4) { const f32x4 br = *(const f32x4*)(p.c_b_re + ((size_t)lg * 64 + lane) * 16 + c4 * 4), bi = *(const f32x4*)(p.c_b_im + ((size_t)lg * 64 + lane) * 16 + c4 * 4);
#pragma unroll
        for (int j = 0; j < 2; ++j) { bbr[c4 * 2 + j] = (f32x2){fre * br[2 * j] - fim * bi[2 * j], fre * br[2 * j + 1] - fim * bi[2 * j + 1]};
                                      bbi[c4 * 2 + j] = (f32x2){fre * bi[2 * j] + fim * br[2 * j], fre * bi[2 * j + 1] + fim * br[2 * j + 1]}; } }
    bf16x8 Cf[4];
#pragma unroll
    for (int ks = 0; ks < 4; ++ks)
#pragma unroll
        for (int jj = 0; jj < 8; ++jj) { const int k = (ks & 1) * 32 + quad * 8 + jj;
            const float v = (ks < 2) ? p.c_c_re[((size_t)lg * 16 + l15) * 64 + k] : -p.c_c_im[((size_t)lg * 16 + l15) * 64 + k];
            Cf[ks][jj] = (short)f2bf(v); }
    const float dsk = p.c_d[lg * 16 + l15];
    float xr = 0.f, xi = 0.f;
    const int utt = lane >> 1, uh = lane & 1;
    u32x4 upre = *(const u32x4*)(P + (size_t)utt * PW + uh * 8);
    for (int ch = 0; ch < S_ / 32; ++ch) {
        const int t0 = ch * 32;
        { const u32x4 w = upre;
          *(f32x4*)(U + utt * 16 + uh * 8) = (f32x4){bflo(w.x), bfhi(w.x), bflo(w.y), bfhi(w.y)};
          *(f32x4*)(U + utt * 16 + uh * 8 + 4) = (f32x4){bflo(w.z), bfhi(w.z), bflo(w.w), bfhi(w.w)}; }
        if (ch + 1 < S_ / 32) upre = *(const u32x4*)(P + (size_t)(t0 + 32 + utt) * PW + uh * 8);
        wave_lds_fence();
#pragma unroll 32
        for (int tt = 0; tt < 32; ++tt) {
            const f32x4 u0 = *(const f32x4*)(U + tt * 16), u1 = *(const f32x4*)(U + tt * 16 + 4), u2 = *(const f32x4*)(U + tt * 16 + 8), u3 = *(const f32x4*)(U + tt * 16 + 12);
            const f32x2 uu[8] = {{u0[0], u0[1]}, {u0[2], u0[3]}, {u1[0], u1[1]}, {u1[2], u1[3]}, {u2[0], u2[1]}, {u2[2], u2[3]}, {u3[0], u3[1]}, {u3[2], u3[3]}};
            f32x2 br2 = bbr[0] * uu[0], bi2 = bbi[0] * uu[0];
#pragma unroll
            for (int j = 1; j < 8; ++j) { br2 = br2 + bbr[j] * uu[j]; bi2 = bi2 + bbi[j] * uu[j]; }
            const float br = br2[0] + br2[1], bi = bi2[0] + bi2[1];
            const float nr = abr * xr - abi * xi + br, ni = abr * xi + abi * xr + bi;
            xr = nr; xi = ni;
            X[tt * 136 + lane] = f2bf(xr); X[tt * 136 + 64 + lane] = f2bf(xi);
        }
        wave_lds_fence();
#pragma unroll
        for (int rt = 0; rt < 2; ++rt) {
            f32x4 acc = {0.f, 0.f, 0.f, 0.f};
#pragma unroll
            for (int ks = 0; ks < 4; ++ks) { const bf16x8 a = *(const bf16x8*)(X + (rt * 16 + l15) * 136 + ks * 32 + quad * 8); acc = MFMA16(a, Cf[ks], acc); }
#pragma unroll
            for (int jj = 0; jj < 4; ++jj) { const int tt = rt * 16 + quad * 4 + jj;
                const float y = acc[jj] + dsk * U[tt * 16 + l15];
                const float gl = 0.5f * y * (1.0f + tanhf_(0.7978845608028654f * (y + 0.044715f * y * y * y)));
                Cp[(size_t)(t0 + tt) * 512 + l15] = f2bf(gl); }
        }
        wave_lds_fence();
    }
}


#ifdef DBG_STOP
__device__ __forceinline__ void phase_dump(const int tid, const int bid, const int gsz, const Params& p, int mode) {
    const int lane = tid & 63, wid = tid >> 6;
    const bf16_t* Pj = (const bf16_t*)(p.ws + P_OFF); const bf16_t* Cp = (const bf16_t*)(p.ws + CPRE_OFF); const bf16_t* Xb = (const bf16_t*)(p.ws + XBF_OFF);
    const bf16_t* Mg = (const bf16_t*)(p.ws + MG_OFF);
    for (int row = bid * 8 + wid; row < T_; row += gsz * 8) {
        float v[16];
#pragma unroll
        for (int j = 0; j < 16; ++j) { const int c = lane + 64 * j; float a = 0.f;
            if (mode == 1) { for (int k = 0; k < 5; ++k) a += bf2f(Pj[(size_t)row * PW + c + 1024 * k]); a += bf2f(Pj[(size_t)row * PW + 5120 + (c & 255)]); }
            if (mode == 2) { const bf16_t* Y = (const bf16_t*)p.out; a = bf2f(Y[(size_t)row * 2048 + c]) + bf2f(Y[(size_t)row * 2048 + 1024 + (c & 511)]) + bf2f(Cp[(size_t)row * 512 + (c & 511)]); }
            if (mode == 3) { const bf16_t* Y = (const bf16_t*)p.out; a = bf2f(Y[(size_t)row * 2048 + 1024 + c]) + bf2f(Pj[(size_t)row * 3072 + c]) + bf2f(Pj[(size_t)row * 3072 + 1024 + c]) + bf2f(Pj[(size_t)row * 3072 + 2048 + c]); }
            if (mode == 21) { const bf16_t* Y = (const bf16_t*)p.out; a = bf2f(Y[(size_t)row * 2048 + (c & 511)]); }
            if (mode == 22) { const bf16_t* Y = (const bf16_t*)p.out; a = bf2f(Y[(size_t)row * 2048 + 512 + c]); }
            if (mode == 23) a = bf2f(Cp[(size_t)row * 512 + (c & 511)]);
            if (mode == 4) a = bf2f(Mg[(size_t)row * 1024 + c]);
            if (mode == 5) a = p.out[(size_t)row * 1024 + c];
            if (mode == 6) a = bf2f(Xb[(size_t)row * 1024 + c]);
            if (mode == 7) { for (int k = 0; k < 4; ++k) a += bf2f(Pj[(size_t)row * 4096 + c + 1024 * k]); }
            v[j] = a; }
        asm volatile("s_waitcnt vmcnt(0)" ::: "memory");
#pragma unroll
        for (int j = 0; j < 16; ++j) p.out[(size_t)row * 1024 + lane + 64 * j] = v[j];
    }
}
#endif
constexpr int PH_PER_LAYER = 10, N_PHASES = 2 * PH_PER_LAYER;
typedef const __attribute__((address_space(4))) Params* KP;
template <int PHC> __device__ __forceinline__ void run_phase(KP kp, unsigned char* smem) {
    int ph = PHC;
    int tid = threadIdx.x; asm volatile("" : "+v"(tid));
    int bid = blockIdx.x, gsz = gridDim.x;
    asm volatile("" : "+s"(kp), "+s"(bid), "+s"(gsz));
    Params p;
    { const __attribute__((address_space(4))) unsigned long long* s_ = (const __attribute__((address_space(4))) unsigned long long*)kp;
#define PIN_(i) ((const float*)(const __attribute__((address_space(1))) float*)s_[i])
      p.x = PIN_(0);
      p.w_in = PIN_(1);
      p.b_gate = PIN_(2);
      p.a_shift = PIN_(3);
      p.a_w0 = PIN_(4);
      p.a_w2 = PIN_(5);
      p.a_a0 = PIN_(6);
      p.a_a2 = PIN_(7);
      p.a_g2 = PIN_(8);
      p.a_kk = PIN_(9);
      p.a_ka = PIN_(10);
      p.a_rk = PIN_(11);
      p.a_lnx_g = PIN_(12);
      p.a_lnx_b = PIN_(13);
      p.c_lam_re = PIN_(14);
      p.c_lam_im = PIN_(15);
      p.c_log_dt = PIN_(16);
      p.c_b_re = PIN_(17);
      p.c_b_im = PIN_(18);
      p.c_c_re = PIN_(19);
      p.c_c_im = PIN_(20);
      p.c_d = PIN_(21);
      p.c_w_glu = PIN_(22);
      p.c_b_glu = PIN_(23);
      p.w_branch = PIN_(24);
      p.w_out = PIN_(25);
      p.ln1_g = PIN_(26);
      p.ln1_b = PIN_(27);
      p.w_ff1 = PIN_(28);
      p.w_ff2 = PIN_(29);
      p.ln2_g = PIN_(30);
      p.ln2_b = PIN_(31);
#undef PIN_
      p.out = (float*)(__attribute__((address_space(1))) float*)s_[32];
      p.ws = (unsigned char*)(__attribute__((address_space(1))) unsigned char*)s_[33]; }
    constexpr int l = PHC / PH_PER_LAYER, q = PHC % PH_PER_LAYER;
    bf16_t* W = (bf16_t*)(p.ws + W_OFF + (size_t)l * 40 * MiB);
    bf16_t* Xbf = (bf16_t*)(p.ws + XBF_OFF);
    bf16_t* Pj = (bf16_t*)(p.ws + P_OFF);
    bf16_t* Gt = (bf16_t*)(p.ws + GT_OFF);
    bf16_t* Mg = (bf16_t*)(p.ws + MG_OFF);
    bf16_t* Hb = (bf16_t*)(p.ws + H_OFF);
    bf16_t* Cp = (bf16_t*)(p.ws + CPRE_OFF);
    bf16_t* Yb = (bf16_t*)p.out;
    bf16_t* Pre = (bf16_t*)(p.ws + PRE_OFF);
#ifdef ONLY_Q
    if (q != ONLY_Q) return;
#endif
#ifdef DBG_STOP
    if (ph == DBG_STOP) { phase_dump(tid, bid, gsz, p, DBG_MODE); return; }
    if (ph > DBG_STOP) return;
#endif
    switch (q) {
    case 0: if (l == 0) phase_convert(tid, bid, gsz, p, 0, smem); break;
    case 1: { EpiStore E; E.O = Pj; E.ldc = PW; run_gemm(tid, bid, gsz, smem, Xbf, 1024, W + WT_IN, 1024, PW, 1024, E); } break;
    case 2:
        for (int item = bid; item < 256; item += gsz) {
            asm volatile("" : "+v"(tid));
#ifdef ONLY_MIX
            if (ONLY_MIX == 0) rwkv_item(tid, p, l, item >> 3, item & 7, smem);
            if (ONLY_MIX == 1) ret_item(tid, p, l, (item - 128) >> 2, (item - 128) & 3, smem);
            if (ONLY_MIX == 2) { const int bg = (item - 192) * 8 + (tid >> 6); s5_wave(tid, p, l, bg >> 5, bg & 31, smem + (tid >> 6) * 10752); }
#else
            if (item < 128) rwkv_item(tid, p, l, item >> 3, item & 7, smem);
            else if (item < 192) ret_item(tid, p, l, (item - 128) >> 2, (item - 128) & 3, smem);
            else { const int bg = (item - 192) * 8 + (tid >> 6); s5_wave(tid, p, l, bg >> 5, bg & 31, smem + (tid >> 6) * 10752); }
#endif
            __syncthreads();
        }
        if (l == 0 && gsz == 256 && bid >= 128) phase_convert(tid, bid - 128, 128, p, 1, smem);
        else if (l == 0 && gsz != 256) phase_convert(tid, bid, gsz, p, 1, smem);
        break;
    case 3: {
        EpiGlu E; E.O = Yb; E.ldc = 2048; E.ocol0 = 1536; E.Yin = Cp; E.ldy = 512; E.bias = p.c_b_glu + l * 512;
        run_gemm(tid, bid, gsz, smem, Cp, 512, W + WT_GLU, 512, 512, 512, E);
        EpiSigmoid E2; E2.O = Gt; E2.ldc = 3072; E2.bias = p.b_gate + l * 3072;
        run_gemm(tid, bid, gsz, smem, Xbf, 1024, W + WT_IN + (size_t)PW * 1024, 1024, 3072, 1024, E2);
    } break;
    case 4: { EpiMerge E; E.O = Mg; E.G = Gt; run_gemm(tid, bid, gsz, smem, Yb, 2048, W + WT_BR, 2048, 1024, 2048, E); } break;
    case 5: { EpiResid E; E.C = Pre; E.X = Xbf; run_gemm(tid, bid, gsz, smem, Mg, 1024, W + WT_OUT, 1024, 1024, 1024, E); } break;
    case 6: phase_ln(tid, bid, gsz, Pre, p.ln1_g + l * 1024, p.ln1_b + l * 1024, Xbf, nullptr); break;
    case 7: { EpiSqRelu E; E.O = Hb; E.ldc = 4096; run_gemm(tid, bid, gsz, smem, Xbf, 1024, W + WT_FF1, 1024, 4096, 1024, E); } break;
    case 8: { EpiResid E; E.C = Pre; E.X = Xbf; run_gemm(tid, bid, gsz, smem, Hb, 4096, W + WT_FF2, 4096, 1024, 4096, E); } break;
    case 9: phase_ln(tid, bid, gsz, Pre, p.ln2_g + l * 1024, p.ln2_b + l * 1024, Xbf, (l == 1) ? p.out : nullptr); break;
    }
}

template <int LO, int HI> __device__ __forceinline__ void run_range(KP kp, unsigned char* smem, const XcdBarrier& xb) {
    if constexpr (LO < HI) {
        run_phase<LO>(kp, smem);
        if constexpr (LO + 1 < HI) {
            if constexpr (LO != PH_PER_LAYER) xcd_barrier(xb);
            run_range<LO + 1, HI>(kp, smem, xb);
        }
    }
}
__global__ void __launch_bounds__(512, 2) mega_fwd(Params p) {
    extern __shared__ __attribute__((aligned(16))) unsigned char smem[];
    KP kp = (KP)__builtin_amdgcn_kernarg_segment_ptr();
    volatile LAS unsigned* st = (volatile LAS unsigned*)((LAS unsigned char*)smem + LDS_BYTES - 16);
    if (threadIdx.x == 0) { st[0] = 0u; st[1] = 0u; }
    __syncthreads();
    const XcdBarrier xb = xcd_barrier_post((unsigned*)(p.ws + BAR_OFF), st);
    if (p.ws == nullptr) cg::this_grid().sync();
    run_range<0, N_PHASES>(kp, smem, xb);
}
#if MK_MULTI
template <int PH> __global__ void __launch_bounds__(512, 2) phase_kernel(Params p) {
    extern __shared__ __attribute__((aligned(16))) unsigned char smem[];
    KP kp = (KP)__builtin_amdgcn_kernarg_segment_ptr();
    run_phase<PH>(kp, smem);
}
template <int PH> static void launch_phases(int grid, const Params& p, hipStream_t stream) {
    if constexpr (PH < N_PHASES) {
        (void)hipFuncSetAttribute((const void*)phase_kernel<PH>, hipFuncAttributeMaxDynamicSharedMemorySize, LDS_BYTES);
        hipLaunchKernelGGL(phase_kernel<PH>, dim3(grid), dim3(512), LDS_BYTES, stream, p);
        launch_phases<PH + 1>(grid, p, stream);
    }
}
#endif

extern "C" void kernel_launch(void* const* d_in, const int* in_sizes, int n_in, void* d_out, int out_size, void* d_ws, size_t ws_size, hipStream_t stream) {
    static int grid = 0;
    if (grid == 0) {
        int dev = 0, cus = 0, per_cu = 0;
        if (n_in != 32 || out_size != T_ * D_ || ws_size < WS_END) { fprintf(stderr, "kernel_launch: unexpected problem (n_in %d, out %d, ws %zu)\n", n_in, out_size, ws_size); grid = -1; return; }
        hipGetDevice(&dev);
        hipDeviceGetAttribute(&cus, hipDeviceAttributeMultiprocessorCount, dev);
        if (hipFuncSetAttribute((const void*)mega_fwd, hipFuncAttributeMaxDynamicSharedMemorySize, LDS_BYTES) != hipSuccess) fprintf(stderr, "kernel_launch: hipFuncSetAttribute failed\n");
        hipOccupancyMaxActiveBlocksPerMultiprocessor(&per_cu, (const void*)mega_fwd, 512, LDS_BYTES);
        (void)hipGetLastError();
        if (per_cu < 1) { fprintf(stderr, "kernel_launch: occupancy query says %d\n", per_cu); per_cu = 1; }
        grid = cus;
    }
    if (grid < 0) return;
    Params p{};
    const float** pp = (const float**)&p;
    for (int i = 0; i < 32; ++i) pp[i] = (const float*)d_in[i];
    p.out = (float*)d_out; p.ws = (unsigned char*)d_ws;
#if MK_MULTI
    launch_phases<0>(grid, p, stream);
#else
    (void)hipMemsetAsync((unsigned char*)d_ws + BAR_OFF, 0, XCD_BAR_WORDS * sizeof(unsigned), stream);
    void* args[] = {&p};
    hipError_t e = hipLaunchCooperativeKernel((const void*)mega_fwd, dim3(grid), dim3(512), args, LDS_BYTES, stream);
    if (e != hipSuccess) fprintf(stderr, "cooperative launch failed: %s (grid %d)\n", hipGetErrorString(e), grid);
#endif
}
```

```cpp
#include <hip/hip_runtime.h>
#include <hip/hip_cooperative_groups.h>
#include <cstdio>
#include <cstdint>
namespace cg = cooperative_groups;

#define LAS __attribute__((address_space(3)))
typedef unsigned short bf16_t;
typedef short bf16x8 __attribute__((ext_vector_type(8)));
typedef float f32x4 __attribute__((ext_vector_type(4)));
typedef float f32x2 __attribute__((ext_vector_type(2)));
typedef unsigned u32x4 __attribute__((ext_vector_type(4)));
typedef unsigned u32x2 __attribute__((ext_vector_type(2)));

#ifndef MK_MULTI
#define MK_MULTI 0
#endif

constexpr int T_ = 32768, S_ = 2048, D_ = 1024;
constexpr int PW = 5376;
constexpr int PTOT = 8448;
constexpr int LDS_BYTES = 163840;
constexpr size_t MiB = 1024ull * 1024ull;
constexpr size_t W_OFF = 0;
constexpr size_t WT_IN = 0, WT_GLU = WT_IN + (size_t)8448 * 1024, WT_BR = WT_GLU + (size_t)512 * 512, WT_OUT = WT_BR + (size_t)1024 * 2048,
                 WT_FF1 = WT_OUT + (size_t)1024 * 1024, WT_FF2 = WT_FF1 + (size_t)4096 * 1024;
constexpr size_t XBF_OFF = 80 * MiB;
constexpr size_t P_OFF = 144 * MiB;
constexpr size_t GT_OFF = P_OFF, MG_OFF = P_OFF + 192 * MiB, H_OFF = P_OFF, PRE_OFF = P_OFF + 256 * MiB;
constexpr size_t CPRE_OFF = 480 * MiB;
constexpr size_t WS_END = 512 * MiB;
constexpr size_t BAR_OFF = 40 * MiB - 65536;
constexpr float DN_ALPHA = 1.41421356237f;

struct Params {
    const float* x; const float* w_in; const float* b_gate; const float* a_shift; const float* a_w0; const float* a_w2;
    const float* a_a0; const float* a_a2; const float* a_g2; const float* a_kk; const float* a_ka; const float* a_rk;
    const float* a_lnx_g; const float* a_lnx_b; const float* c_lam_re; const float* c_lam_im; const float* c_log_dt;
    const float* c_b_re; const float* c_b_im; const float* c_c_re; const float* c_c_im; const float* c_d;
    const float* c_w_glu; const float* c_b_glu; const float* w_branch; const float* w_out; const float* ln1_g; const float* ln1_b;
    const float* w_ff1; const float* w_ff2; const float* ln2_g; const float* ln2_b;
    float* out; unsigned char* ws;
};

__device__ __forceinline__ float bf2f(bf16_t b) { return __uint_as_float(((unsigned)b) << 16); }
__device__ __forceinline__ float bflo(unsigned w) { return __uint_as_float(w << 16); }
__device__ __forceinline__ float bfhi(unsigned w) { return __uint_as_float(w & 0xffff0000u); }
typedef __bf16 bf16x2_t __attribute__((ext_vector_type(2)));
__device__ __forceinline__ unsigned pk2(float lo, float hi) { const f32x2 v = {lo, hi}; const bf16x2_t b = __builtin_convertvector(v, bf16x2_t); return __builtin_bit_cast(unsigned, b); }
__device__ __forceinline__ bf16_t f2bf(float f) { const __bf16 b = (__bf16)f; return __builtin_bit_cast(unsigned short, b); }
__device__ __forceinline__ float sigmoidf_(float x) { return __builtin_amdgcn_rcpf(1.0f + __builtin_amdgcn_exp2f(-1.4426950408889634f * x)); }
__device__ __forceinline__ float tanhf_(float x) { return 1.0f - 2.0f * __builtin_amdgcn_rcpf(1.0f + __builtin_amdgcn_exp2f(2.8853900817779268f * x)); }
template <int CTRL> __device__ __forceinline__ float dppf(float x) { return __int_as_float(__builtin_amdgcn_update_dpp(0, __float_as_int(x), CTRL, 0xF, 0xF, false)); }
__device__ __forceinline__ float sum8(float x) { x += dppf<0xB1>(x); x += dppf<0x4E>(x); x += dppf<0x141>(x); return x; }
__device__ __forceinline__ float sum16(float x) { x += dppf<0xB1>(x); x += dppf<0x4E>(x); x += dppf<0x141>(x); x += dppf<0x140>(x); return x; }
__device__ __forceinline__ float wave_sum(float v) {
#pragma unroll
    for (int o = 1; o < 64; o <<= 1) v += __shfl_xor(v, o);
    return v;
}
__device__ __forceinline__ void wave_lds_fence() { asm volatile("s_waitcnt lgkmcnt(0)" ::: "memory"); __builtin_amdgcn_wave_barrier(); asm volatile("" ::: "memory"); }
#define MFMA16(a, b, c) __builtin_amdgcn_mfma_f32_16x16x32_bf16((a), (b), (c), 0, 0, 0)


#define XB_TMO      128
#define XB_XCNT(j)  (256  + 64 * (j))
#define XB_XSUB(j)  (1280 + 64 * (j))
#define XB_XGEN(j)  (2304 + 64 * (j))
#define XB_TOP      3328
#define XB_TOPGEN   3392
#define XCD_BAR_WORDS 3456
#define XB_SPIN_CAP (1u << 22)
__device__ __forceinline__ unsigned xb_ld(unsigned* p)              { return __hip_atomic_load(p, __ATOMIC_RELAXED, __HIP_MEMORY_SCOPE_AGENT); }
__device__ __forceinline__ unsigned xb_add(unsigned* p, unsigned v) { return __hip_atomic_fetch_add(p, v, __ATOMIC_RELAXED, __HIP_MEMORY_SCOPE_AGENT); }
__device__ __forceinline__ unsigned xb_xcc_id() { return (unsigned)__builtin_amdgcn_s_getreg((3 << 11) | 20) & 0xFu; }
#define XB_SPIN(cond, bar) do { unsigned _sp = 0; while (cond) { __builtin_amdgcn_s_sleep(1); \
    if ((++_sp & 255u) == 0u) { if (xb_ld(&(bar)[XB_TMO])) break; if (_sp > XB_SPIN_CAP) { atomicAdd(&(bar)[XB_TMO], 1u); break; } } } } while (0)
struct XcdBarrier { unsigned* bar; unsigned x; volatile LAS unsigned* st; };
__device__ __forceinline__ XcdBarrier xcd_barrier_post(unsigned* bar, volatile LAS unsigned* st) {
    XcdBarrier b; b.bar = bar; b.x = xb_xcc_id(); b.st = st;
    if (threadIdx.x == 0) (void)xb_add(&bar[XB_XCNT(b.x)], 1u);
    return b;
}
__device__ __forceinline__ void xcd_barrier_complete(unsigned* bar, unsigned x, unsigned& nloc, unsigned& nx) {
    const unsigned G = gridDim.x * gridDim.y * gridDim.z;
    unsigned sum, cnt, mine, sp = 0u;
    for (;;) {
        sum = 0u; cnt = 0u; mine = 0u;
#pragma unroll
        for (unsigned j = 0; j < 16; ++j) { const unsigned c = xb_ld(&bar[XB_XCNT(j)]); sum += c; cnt += (c > 0u) ? 1u : 0u; mine = (j == x) ? c : mine; }
        if (sum == G) break;
        __builtin_amdgcn_s_sleep(1);
        if ((++sp & 255u) == 0u) { if (xb_ld(&bar[XB_TMO])) break; if (sp > XB_SPIN_CAP) { atomicAdd(&bar[XB_TMO], 1u); break; } }
    }
    nloc = mine > 0u ? mine : 1u; nx = cnt > 0u ? cnt : 1u;
}
__device__ __forceinline__ void xcd_barrier(const XcdBarrier& b) {
    asm volatile("s_waitcnt vmcnt(0)" ::: "memory");
    __syncthreads();
    if (threadIdx.x == 0) {
        unsigned* bar = b.bar;
        __builtin_amdgcn_s_waitcnt(0);
        unsigned nloc = b.st[0], nx = b.st[1];
        if (nloc == 0u) { xcd_barrier_complete(bar, b.x, nloc, nx); b.st[0] = nloc; b.st[1] = nx; }
        const unsigned old = xb_add(&bar[XB_XSUB(b.x)], 1u);
        const unsigned gen = old / nloc;
        if (old + 1u == (gen + 1u) * nloc) {
            __builtin_amdgcn_fence(__ATOMIC_RELEASE, "agent");
            asm volatile("s_waitcnt vmcnt(0)" ::: "memory");
            const unsigned og = xb_add(&bar[XB_TOP], 1u);
            const unsigned tg = og / nx;
            if (og + 1u == (tg + 1u) * nx) xb_add(&bar[XB_TOPGEN], 1u);
            else XB_SPIN(xb_ld(&bar[XB_TOPGEN]) == tg, bar);
            __builtin_amdgcn_fence(__ATOMIC_ACQUIRE, "agent");
            xb_add(&bar[XB_XGEN(b.x)], 1u);
            asm volatile("s_waitcnt vmcnt(0)" ::: "memory");
        } else {
            XB_SPIN(xb_ld(&bar[XB_XGEN(b.x)]) == gen, bar);
            __builtin_amdgcn_fence(__ATOMIC_ACQUIRE, "agent");
            asm volatile("s_waitcnt vmcnt(0)" ::: "memory");
        }
    }
    __syncthreads();
}

namespace pg8 {
#ifndef MK_SP2
#define MK_SP2 true
#endif
#ifndef MK_ALIGN
#define MK_ALIGN true
#endif
constexpr bool GEMM_SP2 = MK_SP2, GEMM_ALIGN = MK_ALIGN;
constexpr int BM = 256, BK = 64, HALF = 128, HTB = HALF * BK * 2, STAGE_BYTES = 8 * HTB, NXCD = 8, WGM = 8;
__device__ __forceinline__ int lds_byte(int r, int c) { const int st = (r >> 4) * 2 + (c >> 5), rr = r & 15, cc = c & 31, ob = rr * 64 + cc * 2; return st * 1024 + (ob ^ (((ob >> 9) & 1) << 5)); }
__device__ __forceinline__ void stage_rc(int b, int& R, int& C) { const int st = b / 1024, sb = b % 1024, swz = sb ^ (((sb >> 9) & 1) << 5); R = (st >> 1) * 16 + swz / 64; C = (st & 1) * 32 + (swz % 64) / 2; }
__device__ __forceinline__ int perm32(int rho) { const int n = rho >> 4, i = rho & 15; return 8 * (i >> 2) + 4 * n + (i & 3); }
struct Unit { int pm, pn; };
struct Gemm { const bf16_t* A; const bf16_t* Bt; int M, N, K, lda, ldb; };
struct StaticOrder {
    int nM, nN, nwg, G, c;
    __device__ void init(int M, int N, int G_, int c_) { nM = M / BM; nN = N / BM; nwg = nM * nN; G = G_; c = c_; }
    __device__ bool next(int i, Unit& u) const {
        const long L = (long)i * G + c; if (L >= nwg) return false;
        int wgid = (int)L; { const int q = nwg / NXCD, r = nwg % NXCD, xcd = wgid % NXCD, off = wgid / NXCD; wgid = (xcd < r ? xcd * (q + 1) : r * (q + 1) + (xcd - r) * q) + off; }
        const int nig = WGM * nN, gid = wgid / nig, fm = gid * WGM, gsz = (nM - fm) < WGM ? (nM - fm) : WGM;
        u.pm = fm + ((wgid % nig) % gsz); u.pn = (wgid % nig) / gsz; return true;
    }
};
template <class Epi>
__device__ __forceinline__ void gemm_phase(LAS unsigned char* lds, const Gemm g, const StaticOrder& S, const Epi& E, const int tid) {
    const int wid = __builtin_amdgcn_readfirstlane(tid >> 6), lane = tid & 63, wr = wid >> 2, wc = wid & 3, fr = lane & 15, fq = lane >> 4;
    const int K = g.K, nt = K / BK;
    unsigned voffA[2], voffB[2];
#pragma unroll
    for (int i = 0; i < 2; ++i) { int R, C; stage_rc(tid * 16 + i * 8192, R, C); const int Rb = Epi::PERM ? ((R & ~31) + perm32(R & 31)) : R;
        voffA[i] = (unsigned)(R * g.lda + C) * 2u; voffB[i] = (unsigned)(Rb * g.ldb + C) * 2u; }
    const size_t kstep = (size_t)(BK * 2);
    const size_t hA = (size_t)HALF * g.lda * 2, hB = (size_t)HALF * g.ldb * 2;
    const size_t tA = 2 * hA, tB = 2 * hB;
    const unsigned ldsw = (unsigned)wid * 1024u;
    const int aoff = lds_byte(wr * 64 + fr, fq * 8), boff = lds_byte(wc * 32 + fr, fq * 8);
#define PG8_SA(b, h) (((b) * 2 + (h)) * HTB)
#define PG8_SB(b, h) ((4 + (b) * 2 + (h)) * HTB)
#define PG8_STAGE(bufoff, gbase, voff) do { _Pragma("unroll") for (int _i = 0; _i < 2; ++_i) \
        __builtin_amdgcn_global_load_lds((const unsigned*)((const char*)(gbase) + (voff)[_i]), (LAS unsigned*)(lds + (bufoff) + ldsw + _i * 8192), 16, 0, 0); } while (0)
#define PG8_LDA(dst, b, h) do { _Pragma("unroll") for (int m = 0; m < 4; ++m) _Pragma("unroll") for (int k = 0; k < 2; ++k) dst[m][k] = *(const LAS bf16x8*)(lds + PG8_SA(b, h) + aoff + m * 2048 + k * 1024); } while (0)
#define PG8_LDB(dst, b, h) do { _Pragma("unroll") for (int n = 0; n < 2; ++n) _Pragma("unroll") for (int k = 0; k < 2; ++k) dst[n][k] = *(const LAS bf16x8*)(lds + PG8_SB(b, h) + boff + n * 2048 + k * 1024); } while (0)
#define PG8_MMA(ai, bj, At, Bt) do { __builtin_amdgcn_s_setprio(1); _Pragma("unroll") for (int m = 0; m < 4; ++m) _Pragma("unroll") for (int n = 0; n < 2; ++n) _Pragma("unroll") for (int k = 0; k < 2; ++k) \
        acc[ai][bj][m][n] = __builtin_amdgcn_mfma_f32_16x16x32_bf16(Bt[n][k], At[m][k], acc[ai][bj][m][n], 0, 0, 0); __builtin_amdgcn_s_setprio(0); } while (0)
#define PG8_WAIT_V(n) asm volatile("s_waitcnt vmcnt(" #n ")" ::: "memory")
#define PG8_WAIT_L(n) asm volatile("s_waitcnt lgkmcnt(" #n ")" ::: "memory")
#define PG8_BAR __builtin_amdgcn_s_barrier()
#define PG8_SCHED __builtin_amdgcn_sched_barrier(0)
    Unit cur, nxt; int ui = 0;
    if (!S.next(0, cur)) return;
    f32x4 acc[2][2][4][2];
#pragma unroll
    for (int a = 0; a < 2; ++a)
#pragma unroll
        for (int b = 0; b < 2; ++b)
#pragma unroll
            for (int m = 0; m < 4; ++m)
#pragma unroll
                for (int n = 0; n < 2; ++n) acc[a][b][m][n] = (f32x4){0.f, 0.f, 0.f, 0.f};
    bf16x8 At[4][2], B0[2][2], B1[2][2];
    const char* cA = (const char*)g.A + (size_t)cur.pm * tA; const char* cB = (const char*)g.Bt + (size_t)cur.pn * tB;
    if constexpr (GEMM_SP2) {
        PG8_STAGE(PG8_SB(0, 0), cB, voffB); PG8_STAGE(PG8_SB(0, 1), cB + hB, voffB); PG8_STAGE(PG8_SA(0, 0), cA, voffA); PG8_STAGE(PG8_SA(0, 1), cA + hA, voffA);
        if (wr == 1) PG8_BAR;
        PG8_WAIT_V(2); PG8_BAR;
        PG8_STAGE(PG8_SB(1, 0), cB + kstep, voffB); PG8_STAGE(PG8_SA(1, 0), cA + kstep, voffA); PG8_STAGE(PG8_SB(1, 1), cB + hB + kstep, voffB);
        PG8_WAIT_V(6); PG8_BAR;
    } else {
    PG8_STAGE(PG8_SB(0, 0), cB, voffB); PG8_STAGE(PG8_SA(0, 0), cA, voffA); PG8_STAGE(PG8_SB(0, 1), cB + hB, voffB); PG8_STAGE(PG8_SA(0, 1), cA + hA, voffA);
    if (wr == 1) PG8_BAR;
    PG8_WAIT_V(4); PG8_BAR;
    PG8_STAGE(PG8_SB(1, 0), cB + kstep, voffB); PG8_STAGE(PG8_SA(1, 0), cA + kstep, voffA); PG8_STAGE(PG8_SB(1, 1), cB + hB + kstep, voffB);
    PG8_WAIT_V(6); PG8_BAR;
    }
    for (;;) {
        const bool has_next = S.next(ui + 1, nxt);
        const char* nA = has_next ? (const char*)g.A + (size_t)nxt.pm * tA : cA; const char* nB = has_next ? (const char*)g.Bt + (size_t)nxt.pn * tB : cB;
        for (int t = 0; t < nt; t += 2) {
            const bool last = (t == nt - 2);
            const char* a1 = cA + (size_t)(t + 1) * kstep;
            const char* a2 = last ? nA : cA + (size_t)(t + 2) * kstep; const char* b2 = last ? nB : cB + (size_t)(t + 2) * kstep;
            const char* a3 = a2 + kstep; const char* b3 = b2 + kstep;
            if constexpr (Epi::KHOOK) { if (t == 8 || t == 24) E.khook(acc, cur, t, wr, wc, fr, fq); }
            if constexpr (GEMM_SP2) {
            PG8_LDB(B0, 0, 0); PG8_LDB(B1, 0, 1); PG8_SCHED; PG8_LDA(At, 0, 0); PG8_STAGE(PG8_SA(1, 1), a1 + hA, voffA);
            PG8_WAIT_V(8); PG8_WAIT_L(0); PG8_BAR; PG8_MMA(0, 0, At, B0); PG8_MMA(0, 1, At, B1); PG8_BAR; PG8_SCHED;
            PG8_LDA(At, 0, 1); PG8_STAGE(PG8_SB(0, 0), b2, voffB); PG8_STAGE(PG8_SB(0, 1), b2 + hB, voffB); PG8_STAGE(PG8_SA(0, 0), a2, voffA);
            PG8_WAIT_V(8); PG8_WAIT_L(0); PG8_BAR; PG8_MMA(1, 0, At, B0); PG8_MMA(1, 1, At, B1); PG8_BAR; PG8_SCHED;
            PG8_LDB(B0, 1, 0); PG8_LDB(B1, 1, 1); PG8_SCHED; PG8_LDA(At, 1, 0); PG8_STAGE(PG8_SA(0, 1), a2 + hA, voffA);
            PG8_WAIT_V(8); PG8_WAIT_L(0); PG8_BAR; PG8_MMA(0, 0, At, B0); PG8_MMA(0, 1, At, B1); PG8_BAR; PG8_SCHED;
            PG8_LDA(At, 1, 1); PG8_STAGE(PG8_SB(1, 0), b3, voffB); PG8_STAGE(PG8_SB(1, 1), b3 + hB, voffB); PG8_STAGE(PG8_SA(1, 0), a3, voffA);
            PG8_WAIT_V(8); PG8_WAIT_L(0); PG8_BAR; PG8_MMA(1, 0, At, B0); PG8_MMA(1, 1, At, B1); PG8_BAR; PG8_SCHED;
            } else {
            PG8_LDB(B0, 0, 0); PG8_SCHED; PG8_LDA(At, 0, 0); PG8_STAGE(PG8_SA(1, 1), a1 + hA, voffA);
            PG8_WAIT_L(8); PG8_BAR; PG8_WAIT_L(0); PG8_MMA(0, 0, At, B0); PG8_BAR; PG8_SCHED;
            PG8_LDB(B1, 0, 1); PG8_STAGE(PG8_SB(0, 0), b2, voffB);
            PG8_BAR; PG8_WAIT_L(0); PG8_MMA(0, 1, At, B1); PG8_BAR;
            PG8_LDA(At, 0, 1); PG8_STAGE(PG8_SA(0, 0), a2, voffA);
            PG8_BAR; PG8_WAIT_L(0); PG8_MMA(1, 0, At, B0); PG8_BAR; PG8_SCHED;
            PG8_STAGE(PG8_SB(0, 1), b2 + hB, voffB);
            PG8_WAIT_V(6); PG8_BAR; PG8_MMA(1, 1, At, B1); PG8_BAR;
            PG8_LDB(B0, 1, 0); PG8_SCHED; PG8_LDA(At, 1, 0); PG8_STAGE(PG8_SA(0, 1), a2 + hA, voffA);
            PG8_WAIT_L(8); PG8_BAR; PG8_WAIT_L(0); PG8_MMA(0, 0, At, B0); PG8_BAR; PG8_SCHED;
            PG8_LDB(B1, 1, 1); PG8_STAGE(PG8_SB(1, 0), b3, voffB);
            PG8_BAR; PG8_WAIT_L(0); PG8_MMA(0, 1, At, B1); PG8_BAR;
            PG8_LDA(At, 1, 1); PG8_STAGE(PG8_SA(1, 0), a3, voffA);
            PG8_BAR; PG8_WAIT_L(0); PG8_MMA(1, 0, At, B0); PG8_BAR; PG8_SCHED;
            PG8_STAGE(PG8_SB(1, 1), b3 + hB, voffB);
            PG8_WAIT_V(6); PG8_BAR; PG8_MMA(1, 1, At, B1); PG8_BAR;
            }
        }
        if constexpr (GEMM_ALIGN) { if (wr == 0) PG8_BAR; }
        E(acc, cur, wr, wc, fr, fq);
        if (!has_next) break;
#pragma unroll
        for (int a = 0; a < 2; ++a)
#pragma unroll
            for (int b = 0; b < 2; ++b)
#pragma unroll
                for (int m = 0; m < 4; ++m)
#pragma unroll
                    for (int n = 0; n < 2; ++n) acc[a][b][m][n] = (f32x4){0.f, 0.f, 0.f, 0.f};
        cur = nxt; cA = nA; cB = nB; ++ui;
        if constexpr (GEMM_ALIGN) { if (wr == 1) PG8_BAR; }
    }
    PG8_WAIT_V(0);
    if constexpr (!GEMM_ALIGN) { if (wr == 0) PG8_BAR; }
    PG8_BAR;
#undef PG8_SA
#undef PG8_SB
#undef PG8_STAGE
#undef PG8_LDA
#undef PG8_LDB
#undef PG8_MMA
#undef PG8_WAIT_V
#undef PG8_WAIT_L
#undef PG8_BAR
#undef PG8_SCHED
}
}
using pg8::Unit;

#define EPI_FOR_ROWS  _Pragma("unroll") for (int ai = 0; ai < 2; ++ai) _Pragma("unroll") for (int m = 0; m < 4; ++m)
#define EPI_FOR_COLS  _Pragma("unroll") for (int bj = 0; bj < 2; ++bj) _Pragma("unroll") for (int n = 0; n < 2; ++n)
#define EPI_FOR_BJ    _Pragma("unroll") for (int bj = 0; bj < 2; ++bj)
#define EPI_ROW (u.pm * 256 + ai * 128 + wr * 64 + m * 16 + fr)
#define EPI_COL (u.pn * 256 + bj * 128 + wc * 32 + n * 16 + 4 * fq)
#define EPI_COL8 (u.pn * 256 + bj * 128 + wc * 32 + 8 * fq)
typedef f32x4 AccT[2][2][4][2];

__device__ __forceinline__ void st_bf4(bf16_t* p, f32x4 v) { u32x2 w; w.x = pk2(v[0], v[1]); w.y = pk2(v[2], v[3]); *(u32x2*)p = w; }
__device__ __forceinline__ void st_bf8(bf16_t* p, f32x4 v0, f32x4 v1) { u32x4 w; w.x = pk2(v0[0], v0[1]); w.y = pk2(v0[2], v0[3]); w.z = pk2(v1[0], v1[1]); w.w = pk2(v1[2], v1[3]); *(u32x4*)p = w; }
__device__ __forceinline__ f32x4 ld_bf4(const bf16_t* p) { const u32x2 w = *(const u32x2*)p; return (f32x4){bflo(w.x), bfhi(w.x), bflo(w.y), bfhi(w.y)}; }
__device__ __forceinline__ f32x4 bf4lo(u32x4 w) { return (f32x4){bflo(w.x), bfhi(w.x), bflo(w.y), bfhi(w.y)}; }
__device__ __forceinline__ f32x4 bf4hi(u32x4 w) { return (f32x4){bflo(w.z), bfhi(w.z), bflo(w.w), bfhi(w.w)}; }

struct EpiStore {
    static constexpr bool KHOOK = false, PERM = true;
    bf16_t* O; int ldc;
    __device__ __forceinline__ void operator()(const AccT& acc, const Unit& u, int wr, int wc, int fr, int fq) const {
        EPI_FOR_ROWS { bf16_t* rp = O + (size_t)EPI_ROW * ldc; EPI_FOR_BJ st_bf8(rp + EPI_COL8, acc[ai][bj][m][0], acc[ai][bj][m][1]); }
    }
    __device__ __forceinline__ void khook(AccT&, const Unit&, int, int, int, int, int) const {}
};
struct EpiSqRelu {
    static constexpr bool KHOOK = false, PERM = true;
    bf16_t* O; int ldc;
    __device__ __forceinline__ void operator()(const AccT& acc, const Unit& u, int wr, int wc, int fr, int fq) const {
        EPI_FOR_ROWS { bf16_t* rp = O + (size_t)EPI_ROW * ldc; EPI_FOR_BJ { f32x4 v0 = acc[ai][bj][m][0], v1 = acc[ai][bj][m][1];
#pragma unroll
            for (int j = 0; j < 4; ++j) { const float r0 = fmaxf(v0[j], 0.f), r1 = fmaxf(v1[j], 0.f); v0[j] = r0 * r0; v1[j] = r1 * r1; }
            st_bf8(rp + EPI_COL8, v0, v1); } }
    }
    __device__ __forceinline__ void khook(AccT&, const Unit&, int, int, int, int, int) const {}
};
struct EpiSigmoid {
    static constexpr bool KHOOK = false, PERM = true;
    bf16_t* O; int ldc; const float* bias;
    __device__ __forceinline__ void operator()(const AccT& acc, const Unit& u, int wr, int wc, int fr, int fq) const {
        f32x4 bv[2][2];
        EPI_FOR_BJ { const int c = EPI_COL8; bv[bj][0] = *(const f32x4*)(bias + c); bv[bj][1] = *(const f32x4*)(bias + c + 4); }
        EPI_FOR_ROWS { bf16_t* rp = O + (size_t)EPI_ROW * ldc; EPI_FOR_BJ { f32x4 v0 = acc[ai][bj][m][0] + bv[bj][0], v1 = acc[ai][bj][m][1] + bv[bj][1];
#pragma unroll
            for (int j = 0; j < 4; ++j) { v0[j] = sigmoidf_(v0[j]); v1[j] = sigmoidf_(v1[j]); }
            st_bf8(rp + EPI_COL8, v0, v1); } }
    }
    __device__ __forceinline__ void khook(AccT&, const Unit&, int, int, int, int, int) const {}
};
struct EpiGlu {
    static constexpr bool KHOOK = false, PERM = true;
    bf16_t* O; int ldc; int ocol0; const bf16_t* Yin; int ldy; const float* bias;
    __device__ __forceinline__ void operator()(const AccT& acc, const Unit& u, int wr, int wc, int fr, int fq) const {
#pragma unroll
        for (int ai = 0; ai < 2; ++ai) {
            u32x4 yq[4][2];
#pragma unroll
            for (int m = 0; m < 4; ++m) { const size_t row = (size_t)EPI_ROW; EPI_FOR_BJ yq[m][bj] = *(const u32x4*)(Yin + row * ldy + EPI_COL8); }
            __builtin_amdgcn_sched_barrier(0);
#pragma unroll
            for (int m = 0; m < 4; ++m) { const size_t row = (size_t)EPI_ROW; EPI_FOR_BJ { const int c = EPI_COL8; const u32x4 w = yq[m][bj]; const f32x4 y0 = bf4lo(w), y1 = bf4hi(w);
                f32x4 v0 = acc[ai][bj][m][0] + *(const f32x4*)(bias + c), v1 = acc[ai][bj][m][1] + *(const f32x4*)(bias + c + 4);
#pragma unroll
                for (int j = 0; j < 4; ++j) { v0[j] = y0[j] * sigmoidf_(v0[j]); v1[j] = y1[j] * sigmoidf_(v1[j]); }
                st_bf8(O + row * ldc + ocol0 + c, v0, v1); } }
            __builtin_amdgcn_sched_barrier(0);
        }
    }
    __device__ __forceinline__ void khook(AccT&, const Unit&, int, int, int, int, int) const {}
};
struct EpiMerge {
    static constexpr bool KHOOK = true, PERM = true;
    bf16_t* O; const bf16_t* G;
    __device__ __forceinline__ void khook(AccT& acc, const Unit& u, int t, int wr, int wc, int fr, int fq) const {
        unsigned goff = (unsigned)((u.pm * 256 + wr * 64 + fr) * 3072 + u.pn * 256 + wc * 32 + 8 * fq + ((t == 8) ? 0 : 1024)) * 2u;
        asm volatile("" : "+v"(goff));
        const char* gb = (const char*)G;
#pragma unroll
        for (int ai = 0; ai < 2; ++ai) {
            u32x4 q0[4][2], q1[4][2];
#pragma unroll
            for (int m = 0; m < 4; ++m) EPI_FOR_BJ { const unsigned o = goff + (unsigned)(((ai * 128 + m * 16) * 3072 + bj * 128) * 2);
                q0[m][bj] = *(const u32x4*)(gb + o); q1[m][bj] = *(const u32x4*)(gb + o + 2048); }
            __builtin_amdgcn_sched_barrier(0);
#pragma unroll
            for (int m = 0; m < 4; ++m) EPI_FOR_BJ { const u32x4 a = q0[m][bj], b = q1[m][bj];
                const f32x4 g00 = bf4lo(a), g01 = bf4hi(a), g10 = bf4lo(b), g11 = bf4hi(b);
#pragma unroll
                for (int j = 0; j < 4; ++j) { acc[ai][bj][m][0][j] *= g00[j] * __builtin_amdgcn_rcpf(g10[j]); acc[ai][bj][m][1][j] *= g01[j] * __builtin_amdgcn_rcpf(g11[j]); } }
            __builtin_amdgcn_sched_barrier(0);
        }
    }
    __device__ __forceinline__ void operator()(const AccT& acc, const Unit& u, int wr, int wc, int fr, int fq) const {
        u32x4 gq[2][4][2];
        EPI_FOR_ROWS { const size_t row = (size_t)EPI_ROW; EPI_FOR_BJ gq[ai][m][bj] = *(const u32x4*)(G + row * 3072 + 2048 + EPI_COL8); }
        __builtin_amdgcn_sched_barrier(0);
        EPI_FOR_ROWS { const size_t row = (size_t)EPI_ROW; EPI_FOR_BJ { const u32x4 w = gq[ai][m][bj];
            st_bf8(O + row * 1024 + EPI_COL8, acc[ai][bj][m][0] * bf4lo(w), acc[ai][bj][m][1] * bf4hi(w)); } }
    }
};
struct EpiResid {
    static constexpr bool KHOOK = false, PERM = true;
    bf16_t* C; const bf16_t* X;
    __device__ __forceinline__ void operator()(const AccT& acc, const Unit& u, int wr, int wc, int fr, int fq) const {
        u32x4 xq[2][4][2];
        EPI_FOR_ROWS { const size_t row = (size_t)EPI_ROW; EPI_FOR_BJ xq[ai][m][bj] = *(const u32x4*)(X + row * 1024 + EPI_COL8); }
        __builtin_amdgcn_sched_barrier(0);
        EPI_FOR_ROWS { const size_t row = (size_t)EPI_ROW; EPI_FOR_BJ { const u32x4 w = xq[ai][m][bj];
            st_bf8(C + row * 1024 + EPI_COL8, bf4lo(w) * DN_ALPHA + acc[ai][bj][m][0], bf4hi(w) * DN_ALPHA + acc[ai][bj][m][1]); } }
    }
    __device__ __forceinline__ void khook(AccT&, const Unit&, int, int, int, int, int) const {}
};

template <class Epi>
__device__ __forceinline__ void run_gemm(const int tid, const int bid, const int gsz, unsigned char* smem, const bf16_t* A, int lda, const bf16_t* Bt, int ldb, int N, int K, const Epi& E) {
    pg8::Gemm g; g.A = A; g.Bt = Bt; g.M = T_; g.N = N; g.K = K; g.lda = lda; g.ldb = ldb;
    pg8::StaticOrder S; S.init(T_, N, gsz, bid);
    pg8::gemm_phase<Epi>((LAS unsigned char*)smem, g, S, E, tid);
}

__device__ __forceinline__ void transpose_cvt(const int tid, const int bid, const int gsz, const float* __restrict__ src, int K, int N, bf16_t* __restrict__ dst, float* tile) {
    const int tn = N / 64, ntile = (K / 64) * tn;
    for (int t = bid; t < ntile; t += gsz) {
        const int k0 = (t / tn) * 64, n0 = (t % tn) * 64;
#pragma unroll
        for (int r = 0; r < 2; ++r) { const int i = (tid >> 4) + 32 * r, j = (tid & 15) * 4;
            const f32x4 v = *(const f32x4*)(src + (size_t)(k0 + i) * N + n0 + j);
            tile[i * 65 + j] = v[0]; tile[i * 65 + j + 1] = v[1]; tile[i * 65 + j + 2] = v[2]; tile[i * 65 + j + 3] = v[3]; }
        __syncthreads();
        const int jn = tid >> 3, i8 = (tid & 7) * 8;
        u32x4 w;
        w.x = pk2(tile[(i8 + 0) * 65 + jn], tile[(i8 + 1) * 65 + jn]); w.y = pk2(tile[(i8 + 2) * 65 + jn], tile[(i8 + 3) * 65 + jn]);
        w.z = pk2(tile[(i8 + 4) * 65 + jn], tile[(i8 + 5) * 65 + jn]); w.w = pk2(tile[(i8 + 6) * 65 + jn], tile[(i8 + 7) * 65 + jn]);
        *(u32x4*)(dst + (size_t)(n0 + jn) * K + k0 + i8) = w;
        __syncthreads();
    }
}
__device__ __forceinline__ void phase_convert(const int tid, const int bid, const int gsz, const Params& p, int l, unsigned char* smem) {
    float* tile = (float*)smem;
    bf16_t* W = (bf16_t*)(p.ws + W_OFF + (size_t)l * 40 * MiB);
    transpose_cvt(tid, bid, gsz, p.w_in + (size_t)l * 1024 * PTOT, 1024, PTOT, W + WT_IN, tile);
    transpose_cvt(tid, bid, gsz, p.c_w_glu + (size_t)l * 512 * 512, 512, 512, W + WT_GLU, tile);
    transpose_cvt(tid, bid, gsz, p.w_branch + (size_t)l * 2048 * 1024, 2048, 1024, W + WT_BR, tile);
    transpose_cvt(tid, bid, gsz, p.w_out + (size_t)l * 1024 * 1024, 1024, 1024, W + WT_OUT, tile);
    transpose_cvt(tid, bid, gsz, p.w_ff1 + (size_t)l * 1024 * 4096, 1024, 4096, W + WT_FF1, tile);
    transpose_cvt(tid, bid, gsz, p.w_ff2 + (size_t)l * 4096 * 1024, 4096, 1024, W + WT_FF2, tile);
    if (l == 0) {
        bf16_t* X = (bf16_t*)(p.ws + XBF_OFF);
        const size_t n4 = (size_t)T_ * D_ / 4;
        for (size_t i = (size_t)bid * 512 + tid; i < n4; i += (size_t)gsz * 512) {
            const f32x4 v = *(const f32x4*)(p.x + i * 4); st_bf4(X + i * 4, v); }
    }
}

__device__ __forceinline__ void phase_ln(const int tid, const int bid, const int gsz, const bf16_t* src, const float* gam, const float* bet, bf16_t* xbf, float* fout) {
    const int lane = tid & 63, wid = tid >> 6;
    f32x4 gv[4], bv[4];
#pragma unroll
    for (int j = 0; j < 4; ++j) { gv[j] = *(const f32x4*)(gam + lane * 4 + 256 * j); bv[j] = *(const f32x4*)(bet + lane * 4 + 256 * j); }
    for (int row = bid * 8 + wid; row < T_; row += gsz * 8) {
        const bf16_t* rp = src + (size_t)row * D_;
        f32x4 v[4]; float s = 0.f;
#pragma unroll
        for (int j = 0; j < 4; ++j) { v[j] = ld_bf4(rp + lane * 4 + 256 * j); s += (v[j][0] + v[j][1]) + (v[j][2] + v[j][3]); }
        const float mean = wave_sum(s) * (1.f / D_); float s2 = 0.f;
#pragma unroll
        for (int j = 0; j < 4; ++j) { v[j] = v[j] - mean; s2 += (v[j][0] * v[j][0] + v[j][1] * v[j][1]) + (v[j][2] * v[j][2] + v[j][3] * v[j][3]); }
        const float rstd = rsqrtf(wave_sum(s2) * (1.f / D_) + 1e-5f);
#pragma unroll
        for (int j = 0; j < 4; ++j) { const f32x4 o = v[j] * rstd * gv[j] + bv[j];
            st_bf4(xbf + (size_t)row * D_ + lane * 4 + 256 * j, o);
            if (fout) *(f32x4*)(fout + (size_t)row * D_ + lane * 4 + 256 * j) = o; }
    }
}

__device__ __forceinline__ int rwkv_gcol(int vi, int h) { return (vi < 24) ? ((vi >> 3) * 512 + h * 64 + (vi & 7) * 8) : (1536 + (vi - 24) * 8); }
__device__ __forceinline__ void prep_bar(unsigned* cnt, unsigned& gen, int lane) {
    gen += 4u;
    asm volatile("s_waitcnt lgkmcnt(0)" ::: "memory");
    if (lane == 0) __hip_atomic_fetch_add(cnt, 1u, __ATOMIC_RELAXED, __HIP_MEMORY_SCOPE_WORKGROUP);
    while (__hip_atomic_load(cnt, __ATOMIC_RELAXED, __HIP_MEMORY_SCOPE_WORKGROUP) < gen) __builtin_amdgcn_s_sleep(1);
    asm volatile("" ::: "memory");
}
__device__ __forceinline__ void rwkv_item(const int tid, const Params& p, int l, int b, int h, unsigned char* smem) {
    const int lane = tid & 63, wid = tid >> 6, quad = lane >> 4, l15 = lane & 15;
    float* R2 = (float*)smem; float* K2 = R2 + 4096; float* V2 = K2 + 4096; float* W2 = V2 + 4096; float* NA2 = W2 + 4096; float* NB2 = NA2 + 4096;
    float* G2 = NB2 + 4096; float* O2 = G2 + 4096; float* A_ = O2 + 4096; float* RK2 = A_ + 2048;
    bf16_t* ZL = (bf16_t*)(RK2 + 64);
    float* MU = (float*)(ZL + 32 * 264);
    unsigned* SBAR = (unsigned*)(MU + 448);
    const bf16_t* P = (const bf16_t*)(p.ws + P_OFF) + (size_t)b * S_ * PW;
    bf16_t* Y = (bf16_t*)p.out + (size_t)b * S_ * 2048;
    for (int c = tid; c < 448; c += 512) { const int vi = c >> 3; MU[c] = p.a_shift[l * 1792 + rwkv_gcol(vi, h) + (c & 7)]; }
    if (tid == 0) SBAR[0] = 0u;
    __syncthreads();
    if (tid < 256) {
        const int sv = (tid >> 3) & 31, sj = tid & 7;
        f32x2 SA[4], SB[4];
#pragma unroll
        for (int i = 0; i < 4; ++i) { SA[i] = (f32x2){0.f, 0.f}; SB[i] = SA[i]; }
        __syncthreads();
        for (int ch = 0; ch < S_ / 32; ++ch) {
            const int cb = (ch & 1) * 2048;
            const float* Rc = R2 + cb; const float* Kc = K2 + cb; const float* Vc = V2 + cb; const float* Wc = W2 + cb; const float* NAc = NA2 + cb; const float* NBc = NB2 + cb;
            float* Oc = O2 + cb;
            f32x4 cna0, cna1, cw0, cw1, cnb0, cnb1, ckt0, ckt1, cr0, cr1; float cva, cvb;
#define RW_LOAD(tt_) do { const int o_ = (tt_) * 64 + sj * 8; \
            cna0 = *(const f32x4*)(NAc + o_); cna1 = *(const f32x4*)(NAc + o_ + 4); cw0 = *(const f32x4*)(Wc + o_); cw1 = *(const f32x4*)(Wc + o_ + 4); \
            cnb0 = *(const f32x4*)(NBc + o_); cnb1 = *(const f32x4*)(NBc + o_ + 4); ckt0 = *(const f32x4*)(Kc + o_); ckt1 = *(const f32x4*)(Kc + o_ + 4); \
            cr0 = *(const f32x4*)(Rc + o_); cr1 = *(const f32x4*)(Rc + o_ + 4); cva = Vc[(tt_) * 64 + sv]; cvb = Vc[(tt_) * 64 + sv + 32]; } while (0)
            RW_LOAD(0);
            float keepA = 0.f, keepB = 0.f;
#pragma unroll 32
            for (int tt = 0; tt < 32; ++tt) {
                const f32x4 na0 = cna0, na1 = cna1, w0 = cw0, w1 = cw1, nb0 = cnb0, nb1 = cnb1, kt0 = ckt0, kt1 = ckt1, r0 = cr0, r1 = cr1; const float va = cva, vb = cvb;
                { const int tn = (tt + 1) & 31; RW_LOAD(tn); }
                const f32x2 n0 = {na0[0], na0[1]}, n1 = {na0[2], na0[3]}, n2 = {na1[0], na1[1]}, n3 = {na1[2], na1[3]};
                f32x2 pa = SA[0] * n0; pa = SA[1] * n1 + pa; pa = SA[2] * n2 + pa; pa = SA[3] * n3 + pa;
                f32x2 pb = SB[0] * n0; pb = SB[1] * n1 + pb; pb = SB[2] * n2 + pb; pb = SB[3] * n3 + pb;
                float sa = pa[0] + pa[1], sb = pb[0] + pb[1];
                sa = sum8(sa); sb = sum8(sb);
                const f32x2 wv[4] = {{w0[0], w0[1]}, {w0[2], w0[3]}, {w1[0], w1[1]}, {w1[2], w1[3]}};
                const f32x2 nbv[4] = {{nb0[0], nb0[1]}, {nb0[2], nb0[3]}, {nb1[0], nb1[1]}, {nb1[2], nb1[3]}};
                const f32x2 ktv[4] = {{kt0[0], kt0[1]}, {kt0[2], kt0[3]}, {kt1[0], kt1[1]}, {kt1[2], kt1[3]}};
#pragma unroll
                for (int i = 0; i < 4; ++i) { SA[i] = SA[i] * wv[i] + (nbv[i] * sa + ktv[i] * va); SB[i] = SB[i] * wv[i] + (nbv[i] * sb + ktv[i] * vb); }
                const f32x2 q0 = {r0[0], r0[1]}, q1 = {r0[2], r0[3]}, q2 = {r1[0], r1[1]}, q3 = {r1[2], r1[3]};
                f32x2 oa = SA[0] * q0; oa = SA[1] * q1 + oa; oa = SA[2] * q2 + oa; oa = SA[3] * q3 + oa;
                f32x2 ob = SB[0] * q0; ob = SB[1] * q1 + ob; ob = SB[2] * q2 + ob; ob = SB[3] * q3 + ob;
                float xa = oa[0] + oa[1], xb = ob[0] + ob[1];
                xa = sum8(xa); xb = sum8(xb);
                keepA = (sj == (tt & 7)) ? xa : keepA; keepB = (sj == (tt & 7)) ? xb : keepB;
                if ((tt & 7) == 7) { Oc[(tt - 7 + sj) * 64 + sv] = keepA; Oc[(tt - 7 + sj) * 64 + sv + 32] = keepB; }
            }
#undef RW_LOAD
            __syncthreads();
        }
        __syncthreads();
    } else {
        const int st = tid - 256, pw = wid - 4;
        const int ocol = h * 64 + pw * 16 + l15;
        bf16x8 Bw[2], Ba[2], Bg[4];
#pragma unroll
        for (int ks = 0; ks < 2; ++ks)
#pragma unroll
            for (int jj = 0; jj < 8; ++jj) { const int k = ks * 32 + quad * 8 + jj;
                Bw[ks][jj] = (short)f2bf(p.a_w2[((size_t)l * 64 + k) * 512 + ocol]); Ba[ks][jj] = (short)f2bf(p.a_a2[((size_t)l * 64 + k) * 512 + ocol]); }
#pragma unroll
        for (int ks = 0; ks < 4; ++ks)
#pragma unroll
            for (int jj = 0; jj < 8; ++jj) { const int k = ks * 32 + quad * 8 + jj; Bg[ks][jj] = (short)f2bf(p.a_g2[((size_t)l * 128 + k) * 512 + ocol]); }
        const float w0v = p.a_w0[l * 512 + ocol], a0v = p.a_a0[l * 512 + ocol];
        const int ett0 = st >> 4, ecg = st & 15;
        const int hc = l * 512 + h * 64 + ecg * 4;
        const f32x4 kkc = *(const f32x4*)(p.a_kk + hc), kac = *(const f32x4*)(p.a_ka + hc), rkc = *(const f32x4*)(p.a_rk + hc),
                    lng = *(const f32x4*)(p.a_lnx_g + hc), lnb = *(const f32x4*)(p.a_lnx_b + hc);
        int svi, srg;
        if (st < 128) { srg = st >> 5; const int j = st & 31; svi = (j < 24) ? j : (8 + j); }
        else { const int u = st - 128; srg = u / 24; const int j = u - srg * 24; svi = (j < 8) ? (24 + j) : (32 + j); }
        const bool shact = st < 224;
        const float tr_a = (svi < 32) ? 2.0f : 1.0f, tr_b = (svi < 32) ? 2.8853900817779268f : 1.4426950408889634f, tr_c = (svi < 32) ? -1.0f : 0.0f;
        const bf16_t* sptr = P + (size_t)(srg * 8 - 1) * PW + rwkv_gcol(svi, h);
        u32x4 pr[9];
        unsigned gen = 0u;
#define RW_PREFETCH(t0n_) do { if (shact) { _Pragma("unroll") for (int j = 0; j < 9; ++j) { \
        pr[j] = ((t0n_) + srg * 8 - 1 + j >= 0) ? *(const u32x4*)(sptr + (size_t)((t0n_) + j) * PW) : (u32x4){0u, 0u, 0u, 0u}; } } } while (0)
#define RW_SHIFT(nb_) do { if (shact) { float* Rn_ = R2 + (nb_); float* Kn_ = K2 + (nb_); float* Vn_ = V2 + (nb_); const int vi = svi; \
        const f32x4 m0 = *(const f32x4*)(MU + vi * 8), m1 = *(const f32x4*)(MU + vi * 8 + 4); \
        _Pragma("unroll") for (int j = 1; j < 9; ++j) { const int tt = srg * 8 + j - 1; const u32x4 cw = pr[j], pw_ = pr[j - 1]; f32x4 z0, z1; \
            { const f32x4 c0 = {bflo(cw.x), bfhi(cw.x), bflo(cw.y), bfhi(cw.y)}, c1 = {bflo(cw.z), bfhi(cw.z), bflo(cw.w), bfhi(cw.w)}; \
              const f32x4 p0 = {bflo(pw_.x), bfhi(pw_.x), bflo(pw_.y), bfhi(pw_.y)}, p1 = {bflo(pw_.z), bfhi(pw_.z), bflo(pw_.w), bfhi(pw_.w)}; \
              z0 = c0 + m0 * (p0 - c0); z1 = c1 + m1 * (p1 - c1); } \
            if (vi < 24) { float* dst = ((vi < 8) ? Rn_ : (vi < 16) ? Kn_ : Vn_) + tt * 64 + (vi & 7) * 8; *(f32x4*)dst = z0; *(f32x4*)(dst + 4) = z1; } \
            else { if (st >= 128) { _Pragma("unroll") for (int q = 0; q < 4; ++q) { \
                       z0[q] = tr_a * __builtin_amdgcn_rcpf(1.0f + __builtin_amdgcn_exp2f(-tr_b * z0[q])) + tr_c; z1[q] = tr_a * __builtin_amdgcn_rcpf(1.0f + __builtin_amdgcn_exp2f(-tr_b * z1[q])) + tr_c; } } \
                   u32x4 o; o.x = pk2(z0[0], z0[1]); o.y = pk2(z0[2], z0[3]); o.z = pk2(z1[0], z1[1]); o.w = pk2(z1[2], z1[3]); \
                   *(u32x4*)(ZL + tt * 264 + (vi - 24) * 8) = o; } } } } while (0)
#define RW_LORA(nb_) do { _Pragma("unroll") for (int rt = 0; rt < 2; ++rt) { f32x4 cw = {0.f, 0.f, 0.f, 0.f}, ca = cw, cgv = cw; const bf16_t* zrow = ZL + (rt * 16 + l15) * 264 + quad * 8; \
        _Pragma("unroll") for (int ks = 0; ks < 2; ++ks) { const bf16x8 a = *(const bf16x8*)(zrow + ks * 32); cw = MFMA16(a, Bw[ks], cw); } \
        _Pragma("unroll") for (int ks = 0; ks < 2; ++ks) { const bf16x8 a = *(const bf16x8*)(zrow + 64 + ks * 32); ca = MFMA16(a, Ba[ks], ca); } \
        _Pragma("unroll") for (int ks = 0; ks < 4; ++ks) { const bf16x8 a = *(const bf16x8*)(zrow + 128 + ks * 32); cgv = MFMA16(a, Bg[ks], cgv); } \
        _Pragma("unroll") for (int jj = 0; jj < 4; ++jj) { const int tt = rt * 16 + quad * 4 + jj, col = pw * 16 + l15; \
            W2[(nb_) + tt * 64 + col] = __builtin_amdgcn_exp2f(-0.8750387749860377f * sigmoidf_(cw[jj] + w0v)); \
            A_[tt * 64 + col] = sigmoidf_(ca[jj] + a0v); G2[(nb_) + tt * 64 + col] = cgv[jj]; } } } while (0)
#define RW_ELEM(nb_) do { _Pragma("unroll") for (int it = 0; it < 2; ++it) { const int ett = ett0 + 16 * it; const int o = ett * 64 + ecg * 4; float* Kn_ = K2 + (nb_); \
        const f32x4 k4 = *(const f32x4*)(Kn_ + o), a4 = *(const f32x4*)(A_ + o), r4 = *(const f32x4*)(R2 + (nb_) + o); \
        const f32x4 kk = k4 * kkc; float ss = (kk[0] * kk[0] + kk[1] * kk[1]) + (kk[2] * kk[2] + kk[3] * kk[3]); ss = sum16(ss); \
        const float inv = __builtin_amdgcn_rsqf(fmaxf(ss, 1e-24f)); const f32x4 kkn = kk * inv; \
        *(f32x4*)(NA2 + (nb_) + o) = -kkn; *(f32x4*)(NB2 + (nb_) + o) = kkn * a4; \
        const f32x4 kt = k4 * (1.0f + (a4 - 1.0f) * kac); *(f32x4*)(Kn_ + o) = kt; \
        const f32x4 pr_ = r4 * kt * rkc; float rk = (pr_[0] + pr_[1]) + (pr_[2] + pr_[3]); rk = sum16(rk); \
        if (ecg == 0) RK2[((nb_) >> 6) + ett] = rk; } } while (0)
#define RW_OUT(cb_, t0_) do { _Pragma("unroll") for (int it = 0; it < 2; ++it) { const int ett = ett0 + 16 * it; const int o = ett * 64 + ecg * 4; \
        const f32x4 o4 = *(const f32x4*)(O2 + (cb_) + o); float s = (o4[0] + o4[1]) + (o4[2] + o4[3]); s = sum16(s); \
        const float mean = s * (1.f / 64.f); const f32x4 d = o4 - mean; \
        float q = (d[0] * d[0] + d[1] * d[1]) + (d[2] * d[2] + d[3] * d[3]); q = sum16(q); \
        const float rstd = rsqrtf(q * (1.f / 64.f) + 64e-5f); \
        const f32x4 v4 = *(const f32x4*)(V2 + (cb_) + o), g4 = *(const f32x4*)(G2 + (cb_) + o); const float rk = RK2[((cb_) >> 6) + ett]; \
        const f32x4 y = ((d * rstd) * lng + lnb + v4 * rk) * g4; \
        st_bf4(Y + (size_t)((t0_) + ett) * 2048 + h * 64 + ecg * 4, y); } } while (0)
        RW_PREFETCH(0);
        RW_SHIFT(0); RW_PREFETCH(32);
        prep_bar(SBAR, gen, lane);
        RW_LORA(0);
        prep_bar(SBAR, gen, lane);
        RW_ELEM(0);
        __syncthreads();
        for (int ch = 0; ch < S_ / 32; ++ch) {
            const int nb = ((ch + 1) & 1) * 2048;
            if (ch >= 1) RW_OUT(nb, (ch - 1) * 32);
            if (ch + 1 < S_ / 32) {
                prep_bar(SBAR, gen, lane);
                RW_SHIFT(nb);
                if (ch + 2 < S_ / 32) RW_PREFETCH((ch + 2) * 32);
                prep_bar(SBAR, gen, lane);
                RW_LORA(nb);
                prep_bar(SBAR, gen, lane);
                RW_ELEM(nb);
            }
            __syncthreads();
        }
        RW_OUT(2048, (S_ / 32 - 1) * 32);
        __syncthreads();
#undef RW_PREFETCH
#undef RW_SHIFT
#undef RW_LORA
#undef RW_ELEM
#undef RW_OUT
    }
}

__device__ __forceinline__ void ret_item(const int tid, const Params& p, int l, int b, int h, unsigned char* smem) {
    const int lane = tid & 63, wid = tid >> 6, quad = lane >> 4, l15 = lane & 15;
    bf16_t* Qs = (bf16_t*)smem;
    bf16_t* Ks = Qs + 32 * 136;
    bf16_t* Kt = Ks + 32 * 136;
    bf16_t* Vt = Kt + 128 * 40;
    bf16_t* Ss = Vt + 256 * 40;
    bf16_t* Rt = Ss + 32 * 40;
    float* Sp = (float*)(Rt + 256 * 136);
    float* Sf = Sp + 512;
    const bf16_t* P = (const bf16_t*)(p.ws + P_OFF) + (size_t)b * S_ * PW;
    bf16_t* Y = (bf16_t*)p.out + (size_t)b * S_ * 2048;
    const float lg2 = log2f(1.0f - exp2f(-5.0f - (float)h));
    const float gC = exp2f(lg2 * 32.f);
    for (int i = tid; i < 256 * 136 / 2; i += 512) ((unsigned*)Rt)[i] = 0u;
    f32x4 accR[8][2];
#pragma unroll
    for (int dt = 0; dt < 8; ++dt) { accR[dt][0] = (f32x4){0.f, 0.f, 0.f, 0.f}; accR[dt][1] = accR[dt][0]; }
    const int ltt = tid >> 4, dg = tid & 15;
    float cfr[4];
#pragma unroll
    for (int q = 0; q < 4; ++q) cfr[q] = exp2f(-(float)(dg + 16 * q) * (13.287712379549449f / 64.f)) * 0.15915494309189535f;
    const float decK = exp2f(lg2 * (float)(31 - ltt));
    const bf16_t* lrow = P + (size_t)ltt * PW + h * 128 + dg;
    const bf16_t* vrow = P + (size_t)ltt * PW + 2816 + h * 256 + dg;
    bf16_t pq1[4], pq2[4], pk1[4], pk2_[4], pv[16], pg[2][4][2];
    const bf16_t* grow = P + 3840 + h * 256 + wid * 32 + l15;
#pragma unroll
    for (int q = 0; q < 4; ++q) { pq1[q] = lrow[1792 + 16 * q]; pq2[q] = lrow[1792 + 64 + 16 * q]; pk1[q] = lrow[2304 + 16 * q]; pk2_[q] = lrow[2304 + 64 + 16 * q]; }
#pragma unroll
    for (int c = 0; c < 16; ++c) pv[c] = vrow[16 * c];
    __syncthreads();
    for (int ch = 0; ch < S_ / 32; ++ch) {
#pragma unroll
        for (int rt = 0; rt < 2; ++rt)
#pragma unroll
            for (int jj = 0; jj < 4; ++jj)
#pragma unroll
                for (int ct = 0; ct < 2; ++ct) pg[rt][jj][ct] = grow[(size_t)(ch * 32 + rt * 16 + quad * 4 + jj) * PW + ct * 16];

        const int t0 = ch * 32;
        {
            const int t = t0 + ltt;
#pragma unroll
            for (int q = 0; q < 4; ++q) {
                float rev = (float)t * cfr[q]; rev -= floorf(rev);
                const float cs = __builtin_amdgcn_cosf(rev), sn = __builtin_amdgcn_sinf(rev);
                const float q1 = bf2f(pq1[q]), q2 = bf2f(pq2[q]), k1 = bf2f(pk1[q]), k2 = bf2f(pk2_[q]);
                const float qa = q1 * cs - q2 * sn, qb = q2 * cs + q1 * sn;
                const float ka = (k1 * cs - k2 * sn) * 0.08838834764831845f, kb = (k2 * cs + k1 * sn) * 0.08838834764831845f;
                const int d = dg + 16 * q;
                Qs[ltt * 136 + d] = f2bf(qa); Qs[ltt * 136 + 64 + d] = f2bf(qb);
                Ks[ltt * 136 + d] = f2bf(ka); Ks[ltt * 136 + 64 + d] = f2bf(kb);
                Kt[d * 40 + ltt] = f2bf(ka * decK); Kt[(64 + d) * 40 + ltt] = f2bf(kb * decK);
            }
#pragma unroll
            for (int c = 0; c < 16; ++c) Vt[(dg + 16 * c) * 40 + ltt] = pv[c];
        }
        __syncthreads();
        if (ch + 1 < S_ / 32) {
            const size_t adv = (size_t)(t0 + 32) * PW;
#pragma unroll
            for (int q = 0; q < 4; ++q) { pq1[q] = lrow[adv + 1792 + 16 * q]; pq2[q] = lrow[adv + 1792 + 64 + 16 * q]; pk1[q] = lrow[adv + 2304 + 16 * q]; pk2_[q] = lrow[adv + 2304 + 64 + 16 * q]; }
#pragma unroll
            for (int c = 0; c < 16; ++c) pv[c] = vrow[adv + 16 * c];
        }
        if (wid < 4) {
            const int ri = wid & 1, cj = wid >> 1;
            f32x4 sc = {0.f, 0.f, 0.f, 0.f};
#pragma unroll
            for (int ks = 0; ks < 4; ++ks) { const bf16x8 a = *(const bf16x8*)(Qs + (ri * 16 + l15) * 136 + ks * 32 + quad * 8); const bf16x8 bb = *(const bf16x8*)(Ks + (cj * 16 + l15) * 136 + ks * 32 + quad * 8);
                sc = MFMA16(a, bb, sc); }
#pragma unroll
            for (int jj = 0; jj < 4; ++jj) { const int i = ri * 16 + quad * 4 + jj, j = cj * 16 + l15; const int rel = i - j;
                const float val = (rel >= 0) ? sc[jj] * exp2f(lg2 * (float)rel) : 0.f;
                Ss[i * 40 + j] = f2bf(val); }
        }
        f32x4 ao[2][2];
        ao[0][0] = (f32x4){0.f, 0.f, 0.f, 0.f}; ao[0][1] = ao[0][0]; ao[1][0] = ao[0][0]; ao[1][1] = ao[0][0];
#pragma unroll
        for (int ks = 0; ks < 4; ++ks) {
            const bf16x8 a0 = *(const bf16x8*)(Qs + l15 * 136 + ks * 32 + quad * 8), a1 = *(const bf16x8*)(Qs + (16 + l15) * 136 + ks * 32 + quad * 8);
#pragma unroll
            for (int ct = 0; ct < 2; ++ct) { const bf16x8 bb = *(const bf16x8*)(Rt + (wid * 32 + ct * 16 + l15) * 136 + ks * 32 + quad * 8);
                ao[0][ct] = MFMA16(a0, bb, ao[0][ct]); ao[1][ct] = MFMA16(a1, bb, ao[1][ct]); }
        }
#pragma unroll
        for (int rt = 0; rt < 2; ++rt)
#pragma unroll
            for (int jj = 0; jj < 4; ++jj) { const float s = exp2f(lg2 * (float)(rt * 16 + quad * 4 + jj + 1)); ao[rt][0][jj] *= s; ao[rt][1][jj] *= s; }
        __syncthreads();
        {
            bf16x8 bv[2];
#pragma unroll
            for (int ct = 0; ct < 2; ++ct) bv[ct] = *(const bf16x8*)(Vt + (wid * 32 + ct * 16 + l15) * 40 + quad * 8);
#pragma unroll
            for (int rt = 0; rt < 2; ++rt) { const bf16x8 a = *(const bf16x8*)(Ss + (rt * 16 + l15) * 40 + quad * 8);
                ao[rt][0] = MFMA16(a, bv[0], ao[rt][0]); ao[rt][1] = MFMA16(a, bv[1], ao[rt][1]); }
#pragma unroll
            for (int dt = 0; dt < 8; ++dt) { const bf16x8 a = *(const bf16x8*)(Kt + (dt * 16 + l15) * 40 + quad * 8);
#pragma unroll
                for (int ct = 0; ct < 2; ++ct) { accR[dt][ct] = accR[dt][ct] * gC; accR[dt][ct] = MFMA16(a, bv[ct], accR[dt][ct]);
                    st_bf4(Rt + (wid * 32 + ct * 16 + l15) * 136 + dt * 16 + quad * 4, accR[dt][ct]); } }
        }
#pragma unroll
        for (int rt = 0; rt < 2; ++rt)
#pragma unroll
            for (int jj = 0; jj < 4; ++jj) { const float x0 = ao[rt][0][jj], x1 = ao[rt][1][jj];
                float s = x0 + x1, ss = x0 * x0 + x1 * x1; s = sum16(s); ss = sum16(ss);
                if (l15 == 0) { const int i = rt * 16 + quad * 4 + jj; Sp[(i * 8 + wid) * 2] = s; Sp[(i * 8 + wid) * 2 + 1] = ss; } }
        __syncthreads();
        if (tid < 32) { float s = 0.f, ss = 0.f;
#pragma unroll
            for (int w = 0; w < 8; ++w) { s += Sp[(tid * 8 + w) * 2]; ss += Sp[(tid * 8 + w) * 2 + 1]; }
            const float mean = s * (1.f / 256.f); const float var = fmaxf(ss * (1.f / 256.f) - mean * mean, 0.f);
            Sf[tid * 2] = mean; Sf[tid * 2 + 1] = rsqrtf(var + 1e-5f); }
        __syncthreads();
#pragma unroll
        for (int rt = 0; rt < 2; ++rt)
#pragma unroll
            for (int jj = 0; jj < 4; ++jj) { const int i = rt * 16 + quad * 4 + jj; const float mean = Sf[i * 2], rstd = Sf[i * 2 + 1]; const size_t t = (size_t)(t0 + i);
#pragma unroll
                for (int ct = 0; ct < 2; ++ct) { const int e = wid * 32 + ct * 16 + l15;
                    const float g = bf2f(pg[rt][jj][ct]);
                    const float y = g * sigmoidf_(g) * ((ao[rt][ct][jj] - mean) * rstd);
                    Y[t * 2048 + 512 + h * 256 + e] = f2bf(y); } }
    }
}

__device__ __forceinline__ void s5_wave(const int tid, const Params& p, int l, int b, int g, unsigned char* wsm) {
    const int lane = tid & 63, quad = lane >> 4, l15 = lane & 15;
    float* U = (float*)wsm;
    bf16_t* X = (bf16_t*)(wsm + 2048);
    const bf16_t* P = (const bf16_t*)(p.ws + P_OFF) + (size_t)b * S_ * PW + 4864 + g * 16;
    bf16_t* Cp = (bf16_t*)(p.ws + CPRE_OFF) + (size_t)b * S_ * 512 + g * 16;
    const int lg = l * 32 + g;
    const float dt = expf(p.c_log_dt[lg]);
    const float lr = p.c_lam_re[lg * 64 + lane], li = p.c_lam_im[lg * 64 + lane];
    const float em1 = expm1f(lr * dt);
    const float th = li * dt;
    const float cth = cosf(th), sth = sinf(th), sh = sinf(0.5f * th);
    const float abr = (em1 + 1.0f) * cth, abi = (em1 + 1.0f) * sth;
    const float abr_m1 = em1 * cth - 2.0f * sh * sh;
    const float den = lr * lr + li * li;
    const float fre = (abr_m1 * lr + abi * li) / den, fim = (abi * lr - abr_m1 * li) / den;
    f32x2 bbr[8], bbi[8];
#pragma unroll
    for (int c4 = 0; c4 < 4; ++c4) { const f32x4 br = *(const f32x4*)(p.c_b_re + ((size_t)lg * 64 + lane) * 16 + c4 * 4), bi = *(const f32x4*)(p.c_b_im + ((size_t)lg * 64 + lane) * 16 + c4 * 4);
#pragma unroll
        for (int j = 0; j < 2; ++j) { bbr[c4 * 2 + j] = (f32x2){fre * br[2 * j] - fim * bi[2 * j], fre * br[2 * j + 1] - fim * bi[2 * j + 1]};
                                      bbi[c4 * 2 + j] = (f32x2){fre * bi[2 * j] + fim * br[2 * j], fre * bi[2 * j + 1] + fim * br[2 * j + 1]}; } }
    bf16x8 Cf[4];
#pragma unroll
    for (int ks = 0; ks < 4; ++ks)
#pragma unroll
        for (int jj = 0; jj < 8; ++jj) { const int k = (ks & 1) * 32 + quad * 8 + jj;
            const float v = (ks < 2) ? p.c_c_re[((size_t)lg * 16 + l15) * 64 + k] : -p.c_c_im[((size_t)lg * 16 + l15) * 64 + k];
            Cf[ks][jj] = (short)f2bf(v); }
    const float dsk = p.c_d[lg * 16 + l15];
    float xr = 0.f, xi = 0.f;
    const int utt = lane >> 1, uh = lane & 1;
    u32x4 upre = *(const u32x4*)(P + (size_t)utt * PW + uh * 8);
    for (int ch = 0; ch < S_ / 32; ++ch) {
        const int t0 = ch * 32;
        { const u32x4 w = upre;
          *(f32x4*)(U + utt * 16 + uh * 8) = (f32x4){bflo(w.x), bfhi(w.x), bflo(w.y), bfhi(w.y)};
          *(f32x4*)(U + utt * 16 + uh * 8 + 4) = (f32x4){bflo(w.z), bfhi(w.z), bflo(w.w), bfhi(w.w)}; }
        if (ch + 1 < S_ / 32) upre = *(const u32x4*)(P + (size_t)(t0 + 32 + utt) * PW + uh * 8);
        wave_lds_fence();
#pragma unroll 32
        for (int tt = 0; tt < 32; ++tt) {
            const f32x4 u0 = *(const f32x4*)(U + tt * 16), u1 = *(const f32x4*)(U + tt * 16 + 4), u2 = *(const f32x4*)(U + tt * 16 + 8), u3 = *(const f32x4*)(U + tt * 16 + 12);
            const f32x2 uu[8] = {{u0[0], u0[1]}, {u0[2], u0[3]}, {u1[0], u1[1]}, {u1[2], u1[3]}, {u2[0], u2[1]}, {u2[2], u2[3]}, {u3[0], u3[1]}, {u3[2], u3[3]}};
            f32x2 br2 = bbr[0] * uu[0], bi2 = bbi[0] * uu[0];
#pragma unroll
            for (int j = 1; j < 8; ++j) { br2 = br2 + bbr[j] * uu[j]; bi2 = bi2 + bbi[j] * uu[j]; }
            const float br = br2[0] + br2[1], bi = bi2[0] + bi2[1];
            const float nr = abr * xr - abi * xi + br, ni = abr * xi + abi * xr + bi;
            xr = nr; xi = ni;
            X[tt * 136 + lane] = f2bf(xr); X[tt * 136 + 64 + lane] = f2bf(xi);
        }
        wave_lds_fence();
#pragma unroll
        for (int rt = 0; rt < 2; ++rt) {
            f32x4 acc = {0.f, 0.f, 0.f, 0.f};
#pragma unroll
            for (int ks = 0; ks < 4; ++ks) { const bf16x8 a = *(const bf16x8*)(X + (rt * 16 + l15) * 136 + ks * 32 + quad * 8); acc = MFMA16(a, Cf[ks], acc); }
#pragma unroll
            for (int jj = 0; jj < 4; ++jj) { const int tt = rt * 16 + quad * 4 + jj;
                const float y = acc[jj] + dsk * U[tt * 16 + l15];
                const float gl = 0.5f * y * (1.0f + tanhf_(0.7978845608028654f * (y + 0.044715f * y * y * y)));
                Cp[(size_t)(t0 + tt) * 512 + l15] = f2bf(gl); }
        }
        wave_lds_fence();
    }
}


#ifdef DBG_STOP
__device__ __forceinline__ void phase_dump(const int tid, const int bid, const int gsz, const Params& p, int mode) {
    const int lane = tid & 63, wid = tid >> 6;
    const bf16_t* Pj = (const bf16_t*)(p.ws + P_OFF); const bf16_t* Cp = (const bf16_t*)(p.ws + CPRE_OFF); const bf16_t* Xb = (const bf16_t*)(p.ws + XBF_OFF);
    const bf16_t* Mg = (const bf16_t*)(p.ws + MG_OFF);
    for (int row = bid * 8 + wid; row < T_; row += gsz * 8) {
        float v[16];
#pragma unroll
        for (int j = 0; j < 16; ++j) { const int c = lane + 64 * j; float a = 0.f;
            if (mode == 1) { for (int k = 0; k < 5; ++k) a += bf2f(Pj[(size_t)row * PW + c + 1024 * k]); a += bf2f(Pj[(size_t)row * PW + 5120 + (c & 255)]); }
            if (mode == 2) { const bf16_t* Y = (const bf16_t*)p.out; a = bf2f(Y[(size_t)row * 2048 + c]) + bf2f(Y[(size_t)row * 2048 + 1024 + (c & 511)]) + bf2f(Cp[(size_t)row * 512 + (c & 511)]); }
            if (mode == 3) { const bf16_t* Y = (const bf16_t*)p.out; a = bf2f(Y[(size_t)row * 2048 + 1024 + c]) + bf2f(Pj[(size_t)row * 3072 + c]) + bf2f(Pj[(size_t)row * 3072 + 1024 + c]) + bf2f(Pj[(size_t)row * 3072 + 2048 + c]); }
            if (mode == 21) { const bf16_t* Y = (const bf16_t*)p.out; a = bf2f(Y[(size_t)row * 2048 + (c & 511)]); }
            if (mode == 22) { const bf16_t* Y = (const bf16_t*)p.out; a = bf2f(Y[(size_t)row * 2048 + 512 + c]); }
            if (mode == 23) a = bf2f(Cp[(size_t)row * 512 + (c & 511)]);
            if (mode == 4) a = bf2f(Mg[(size_t)row * 1024 + c]);
            if (mode == 5) a = p.out[(size_t)row * 1024 + c];
            if (mode == 6) a = bf2f(Xb[(size_t)row * 1024 + c]);
            if (mode == 7) { for (int k = 0; k < 4; ++k) a += bf2f(Pj[(size_t)row * 4096 + c + 1024 * k]); }
            v[j] = a; }
        asm volatile("s_waitcnt vmcnt(0)" ::: "memory");
#pragma unroll
        for (int j = 0; j < 16; ++j) p.out[(size_t)row * 1024 + lane + 64 * j] = v[j];
    }
}
#endif
constexpr int PH_PER_LAYER = 10, N_PHASES = 2 * PH_PER_LAYER;
typedef const __attribute__((address_space(4))) Params* KP;
template <int PHC> __device__ __forceinline__ void run_phase(KP kp, unsigned char* smem) {
    int ph = PHC;
    int tid = threadIdx.x; asm volatile("" : "+v"(tid));
    int bid = blockIdx.x, gsz = gridDim.x;
    asm volatile("" : "+s"(kp), "+s"(bid), "+s"(gsz));
    Params p;
    { const __attribute__((address_space(4))) unsigned long long* s_ = (const __attribute__((address_space(4))) unsigned long long*)kp;
#define PIN_(i) ((const float*)(const __attribute__((address_space(1))) float*)s_[i])
      p.x = PIN_(0);
      p.w_in = PIN_(1);
      p.b_gate = PIN_(2);
      p.a_shift = PIN_(3);
      p.a_w0 = PIN_(4);
      p.a_w2 = PIN_(5);
      p.a_a0 = PIN_(6);
      p.a_a2 = PIN_(7);
      p.a_g2 = PIN_(8);
      p.a_kk = PIN_(9);
      p.a_ka = PIN_(10);
      p.a_rk = PIN_(11);
      p.a_lnx_g = PIN_(12);
      p.a_lnx_b = PIN_(13);
      p.c_lam_re = PIN_(14);
      p.c_lam_im = PIN_(15);
      p.c_log_dt = PIN_(16);
      p.c_b_re = PIN_(17);
      p.c_b_im = PIN_(18);
      p.c_c_re = PIN_(19);
      p.c_c_im = PIN_(20);
      p.c_d = PIN_(21);
      p.c_w_glu = PIN_(22);
      p.c_b_glu = PIN_(23);
      p.w_branch = PIN_(24);
      p.w_out = PIN_(25);
      p.ln1_g = PIN_(26);
      p.ln1_b = PIN_(27);
      p.w_ff1 = PIN_(28);
      p.w_ff2 = PIN_(29);
      p.ln2_g = PIN_(30);
      p.ln2_b = PIN_(31);
#undef PIN_
      p.out = (float*)(__attribute__((address_space(1))) float*)s_[32];
      p.ws = (unsigned char*)(__attribute__((address_space(1))) unsigned char*)s_[33]; }
    constexpr int l = PHC / PH_PER_LAYER, q = PHC % PH_PER_LAYER;
    bf16_t* W = (bf16_t*)(p.ws + W_OFF + (size_t)l * 40 * MiB);
    bf16_t* Xbf = (bf16_t*)(p.ws + XBF_OFF);
    bf16_t* Pj = (bf16_t*)(p.ws + P_OFF);
    bf16_t* Gt = (bf16_t*)(p.ws + GT_OFF);
    bf16_t* Mg = (bf16_t*)(p.ws + MG_OFF);
    bf16_t* Hb = (bf16_t*)(p.ws + H_OFF);
    bf16_t* Cp = (bf16_t*)(p.ws + CPRE_OFF);
    bf16_t* Yb = (bf16_t*)p.out;
    bf16_t* Pre = (bf16_t*)(p.ws + PRE_OFF);
#ifdef ONLY_Q
    if (q != ONLY_Q) return;
#endif
#ifdef DBG_STOP
    if (ph == DBG_STOP) { phase_dump(tid, bid, gsz, p, DBG_MODE); return; }
    if (ph > DBG_STOP) return;
#endif
    switch (q) {
    case 0: if (l == 0) phase_convert(tid, bid, gsz, p, 0, smem); break;
    case 1: { EpiStore E; E.O = Pj; E.ldc = PW; run_gemm(tid, bid, gsz, smem, Xbf, 1024, W + WT_IN, 1024, PW, 1024, E); } break;
    case 2:
        for (int item = bid; item < 256; item += gsz) {
            asm volatile("" : "+v"(tid));
#ifdef ONLY_MIX
            if (ONLY_MIX == 0) rwkv_item(tid, p, l, item >> 3, item & 7, smem);
            if (ONLY_MIX == 1) ret_item(tid, p, l, (item - 128) >> 2, (item - 128) & 3, smem);
            if (ONLY_MIX == 2) { const int bg = (item - 192) * 8 + (tid >> 6); s5_wave(tid, p, l, bg >> 5, bg & 31, smem + (tid >> 6) * 10752); }
#else
            if (item < 128) rwkv_item(tid, p, l, item >> 3, item & 7, smem);
            else if (item < 192) ret_item(tid, p, l, (item - 128) >> 2, (item - 128) & 3, smem);
            else { const int bg = (item - 192) * 8 + (tid >> 6); s5_wave(tid, p, l, bg >> 5, bg & 31, smem + (tid >> 6) * 10752); }
#endif
            __syncthreads();
        }
        if (l == 0 && gsz == 256 && bid >= 128) phase_convert(tid, bid - 128, 128, p, 1, smem);
        else if (l == 0 && gsz != 256) phase_convert(tid, bid, gsz, p, 1, smem);
        break;
    case 3: {
        EpiGlu E; E.O = Yb; E.ldc = 2048; E.ocol0 = 1536; E.Yin = Cp; E.ldy = 512; E.bias = p.c_b_glu + l * 512;
        run_gemm(tid, bid, gsz, smem, Cp, 512, W + WT_GLU, 512, 512, 512, E);
        EpiSigmoid E2; E2.O = Gt; E2.ldc = 3072; E2.bias = p.b_gate + l * 3072;
        run_gemm(tid, bid, gsz, smem, Xbf, 1024, W + WT_IN + (size_t)PW * 1024, 1024, 3072, 1024, E2);
    } break;
    case 4: { EpiMerge E; E.O = Mg; E.G = Gt; run_gemm(tid, bid, gsz, smem, Yb, 2048, W + WT_BR, 2048, 1024, 2048, E); } break;
    case 5: { EpiResid E; E.C = Pre; E.X = Xbf; run_gemm(tid, bid, gsz, smem, Mg, 1024, W + WT_OUT, 1024, 1024, 1024, E); } break;
    case 6: phase_ln(tid, bid, gsz, Pre, p.ln1_g + l * 1024, p.ln1_b + l * 1024, Xbf, nullptr); break;
    case 7: { EpiSqRelu E; E.O = Hb; E.ldc = 4096; run_gemm(tid, bid, gsz, smem, Xbf, 1024, W + WT_FF1, 1024, 4096, 1024, E); } break;
    case 8: { EpiResid E; E.C = Pre; E.X = Xbf; run_gemm(tid, bid, gsz, smem, Hb, 4096, W + WT_FF2, 4096, 1024, 4096, E); } break;
    case 9: phase_ln(tid, bid, gsz, Pre, p.ln2_g + l * 1024, p.ln2_b + l * 1024, Xbf, (l == 1) ? p.out : nullptr); break;
    }
}

template <int LO, int HI> __device__ __forceinline__ void run_range(KP kp, unsigned char* smem, const XcdBarrier& xb) {
    if constexpr (LO < HI) {
        run_phase<LO>(kp, smem);
        if constexpr (LO + 1 < HI) {
            if constexpr (LO != PH_PER_LAYER) xcd_barrier(xb);
            run_range<LO + 1, HI>(kp, smem, xb);
        }
    }
}
__global__ void __launch_bounds__(512, 2) mega_fwd(Params p) {
    extern __shared__ __attribute__((aligned(16))) unsigned char smem[];
    KP kp = (KP)__builtin_amdgcn_kernarg_segment_ptr();
    volatile LAS unsigned* st = (volatile LAS unsigned*)((LAS unsigned char*)smem + LDS_BYTES - 16);
    if (threadIdx.x == 0) { st[0] = 0u; st[1] = 0u; }
    __syncthreads();
    const XcdBarrier xb = xcd_barrier_post((unsigned*)(p.ws + BAR_OFF), st);
    if (p.ws == nullptr) cg::this_grid().sync();
    run_range<0, N_PHASES>(kp, smem, xb);
}
#if MK_MULTI
template <int PH> __global__ void __launch_bounds__(512, 2) phase_kernel(Params p) {
    extern __shared__ __attribute__((aligned(16))) unsigned char smem[];
    KP kp = (KP)__builtin_amdgcn_kernarg_segment_ptr();
    run_phase<PH>(kp, smem);
}
template <int PH> static void launch_phases(int grid, const Params& p, hipStream_t stream) {
    if constexpr (PH < N_PHASES) {
        (void)hipFuncSetAttribute((const void*)phase_kernel<PH>, hipFuncAttributeMaxDynamicSharedMemorySize, LDS_BYTES);
        hipLaunchKernelGGL(phase_kernel<PH>, dim3(grid), dim3(512), LDS_BYTES, stream, p);
        launch_phases<PH + 1>(grid, p, stream);
    }
}
#endif

extern "C" void kernel_launch(void* const* d_in, const int* in_sizes, int n_in, void* d_out, int out_size, void* d_ws, size_t ws_size, hipStream_t stream) {
    static int grid = 0;
    if (grid == 0) {
        int dev = 0, cus = 0, per_cu = 0;
        if (n_in != 32 || out_size != T_ * D_ || ws_size < WS_END) { fprintf(stderr, "kernel_launch: unexpected problem (n_in %d, out %d, ws %zu)\n", n_in, out_size, ws_size); grid = -1; return; }
        hipGetDevice(&dev);
        hipDeviceGetAttribute(&cus, hipDeviceAttributeMultiprocessorCount, dev);
        if (hipFuncSetAttribute((const void*)mega_fwd, hipFuncAttributeMaxDynamicSharedMemorySize, LDS_BYTES) != hipSuccess) fprintf(stderr, "kernel_launch: hipFuncSetAttribute failed\n");
        hipOccupancyMaxActiveBlocksPerMultiprocessor(&per_cu, (const void*)mega_fwd, 512, LDS_BYTES);
        (void)hipGetLastError();
        if (per_cu < 1) { fprintf(stderr, "kernel_launch: occupancy query says %d\n", per_cu); per_cu = 1; }
        grid = cus;
    }
    if (grid < 0) return;
    Params p{};
    const float** pp = (const float**)&p;
    for (int i = 0; i < 32; ++i) pp[i] = (const float*)d_in[i];
    p.out = (float*)d_out; p.ws = (unsigned char*)d_ws;
#if MK_MULTI
    launch_phases<0>(grid, p, stream);
#else
    (void)hipMemsetAsync((unsigned char*)d_ws + BAR_OFF, 0, XCD_BAR_WORDS * sizeof(unsigned), stream);
    void* args[] = {&p};
    hipError_t e = hipLaunchCooperativeKernel((const void*)mega_fwd, dim3(grid), dim3(512), args, LDS_BYTES, stream);
    if (e != hipSuccess) fprintf(stderr, "cooperative launch failed: %s (grid %d)\n", hipGetErrorString(e), grid);
#endif
}
```

```cpp
#include <hip/hip_runtime.h>
#include <hip/hip_cooperative_groups.h>
#include <cstdio>
#include <cstdint>
namespace cg = cooperative_groups;

#define LAS __attribute__((address_space(3)))
typedef unsigned short bf16_t;
typedef short bf16x8 __attribute__((ext_vector_type(8)));
typedef float f32x4 __attribute__((ext_vector_type(4)));
typedef float f32x2 __attribute__((ext_vector_type(2)));
typedef unsigned u32x4 __attribute__((ext_vector_type(4)));
typedef unsigned u32x2 __attribute__((ext_vector_type(2)));

#ifndef MK_MULTI
#define MK_MULTI 0
#endif

constexpr int T_ = 32768, S_ = 2048, D_ = 1024;
constexpr int PW = 5376;
constexpr int PTOT = 8448;
constexpr int LDS_BYTES = 163840;
constexpr size_t MiB = 1024ull * 1024ull;
constexpr size_t W_OFF = 0;
constexpr size_t WT_IN = 0, WT_GLU = WT_IN + (size_t)8448 * 1024, WT_BR = WT_GLU + (size_t)512 * 512, WT_OUT = WT_BR + (size_t)1024 * 2048,
                 WT_FF1 = WT_OUT + (size_t)1024 * 1024, WT_FF2 = WT_FF1 + (size_t)4096 * 1024;
constexpr size_t XBF_OFF = 80 * MiB;
constexpr size_t P_OFF = 144 * MiB;
constexpr size_t GT_OFF = P_OFF, MG_OFF = P_OFF + 192 * MiB, H_OFF = P_OFF, PRE_OFF = P_OFF + 256 * MiB;
constexpr size_t CPRE_OFF = 480 * MiB;
constexpr size_t WS_END = 512 * MiB;
constexpr size_t BAR_OFF = 40 * MiB - 65536;
constexpr float DN_ALPHA = 1.41421356237f;

struct Params {
    const float* x; const float* w_in; const float* b_gate; const float* a_shift; const float* a_w0; const float* a_w2;
    const float* a_a0; const float* a_a2; const float* a_g2; const float* a_kk; const float* a_ka; const float* a_rk;
    const float* a_lnx_g; const float* a_lnx_b; const float* c_lam_re; const float* c_lam_im; const float* c_log_dt;
    const float* c_b_re; const float* c_b_im; const float* c_c_re; const float* c_c_im; const float* c_d;
    const float* c_w_glu; const float* c_b_glu; const float* w_branch; const float* w_out; const float* ln1_g; const float* ln1_b;
    const float* w_ff1; const float* w_ff2; const float* ln2_g; const float* ln2_b;
    float* out; unsigned char* ws;
};

__device__ __forceinline__ float bf2f(bf16_t b) { return __uint_as_float(((unsigned)b) << 16); }
__device__ __forceinline__ float bflo(unsigned w) { return __uint_as_float(w << 16); }
__device__ __forceinline__ float bfhi(unsigned w) { return __uint_as_float(w & 0xffff0000u); }
typedef __bf16 bf16x2_t __attribute__((ext_vector_type(2)));
__device__ __forceinline__ unsigned pk2(float lo, float hi) { const f32x2 v = {lo, hi}; const bf16x2_t b = __builtin_convertvector(v, bf16x2_t); return __builtin_bit_cast(unsigned, b); }
__device__ __forceinline__ bf16_t f2bf(float f) { const __bf16 b = (__bf16)f; return __builtin_bit_cast(unsigned short, b); }
__device__ __forceinline__ float sigmoidf_(float x) { return __builtin_amdgcn_rcpf(1.0f + __builtin_amdgcn_exp2f(-1.4426950408889634f * x)); }
__device__ __forceinline__ float tanhf_(float x) { return 1.0f - 2.0f * __builtin_amdgcn_rcpf(1.0f + __builtin_amdgcn_exp2f(2.8853900817779268f * x)); }
template <int CTRL> __device__ __forceinline__ float dppf(float x) { return __int_as_float(__builtin_amdgcn_update_dpp(0, __float_as_int(x), CTRL, 0xF, 0xF, false)); }
__device__ __forceinline__ float sum8(float x) { x += dppf<0xB1>(x); x += dppf<0x4E>(x); x += dppf<0x141>(x); return x; }
__device__ __forceinline__ float sum16(float x) { x += dppf<0xB1>(x); x += dppf<0x4E>(x); x += dppf<0x141>(x); x += dppf<0x140>(x); return x; }
__device__ __forceinline__ float wave_sum(float v) {
#pragma unroll
    for (int o = 1; o < 64; o <<= 1) v += __shfl_xor(v, o);
    return v;
}
__device__ __forceinline__ void wave_lds_fence() { asm volatile("s_waitcnt lgkmcnt(0)" ::: "memory"); __builtin_amdgcn_wave_barrier(); asm volatile("" ::: "memory"); }
#define MFMA16(a, b, c) __builtin_amdgcn_mfma_f32_16x16x32_bf16((a), (b), (c), 0, 0, 0)


#define XB_TMO      128
#define XB_XCNT(j)  (256  + 64 * (j))
#define XB_XSUB(j)  (1280 + 64 * (j))
#define XB_XGEN(j)  (2304 + 64 * (j))
#define XB_TOP      3328
#define XB_TOPGEN   3392
#define XCD_BAR_WORDS 3456
#define XB_SPIN_CAP (1u << 22)
__device__ __forceinline__ unsigned xb_ld(unsigned* p)              { return __hip_atomic_load(p, __ATOMIC_RELAXED, __HIP_MEMORY_SCOPE_AGENT); }
__device__ __forceinline__ unsigned xb_add(unsigned* p, unsigned v) { return __hip_atomic_fetch_add(p, v, __ATOMIC_RELAXED, __HIP_MEMORY_SCOPE_AGENT); }
__device__ __forceinline__ unsigned xb_xcc_id() { return (unsigned)__builtin_amdgcn_s_getreg((3 << 11) | 20) & 0xFu; }
#define XB_SPIN(cond, bar) do { unsigned _sp = 0; while (cond) { __builtin_amdgcn_s_sleep(1); \
    if ((++_sp & 255u) == 0u) { if (xb_ld(&(bar)[XB_TMO])) break; if (_sp > XB_SPIN_CAP) { atomicAdd(&(bar)[XB_TMO], 1u); break; } } } } while (0)
struct XcdBarrier { unsigned* bar; unsigned x; volatile LAS unsigned* st; };
__device__ __forceinline__ XcdBarrier xcd_barrier_post(unsigned* bar, volatile LAS unsigned* st) {
    XcdBarrier b; b.bar = bar; b.x = xb_xcc_id(); b.st = st;
    if (threadIdx.x == 0) (void)xb_add(&bar[XB_XCNT(b.x)], 1u);
    return b;
}
__device__ __forceinline__ void xcd_barrier_complete(unsigned* bar, unsigned x, unsigned& nloc, unsigned& nx) {
    const unsigned G = gridDim.x * gridDim.y * gridDim.z;
    unsigned sum, cnt, mine, sp = 0u;
    for (;;) {
        sum = 0u; cnt = 0u; mine = 0u;
#pragma unroll
        for (unsigned j = 0; j < 16; ++j) { const unsigned c = xb_ld(&bar[XB_XCNT(j)]); sum += c; cnt += (c > 0u) ? 1u : 0u; mine = (j == x) ? c : mine; }
        if (sum == G) break;
        __builtin_amdgcn_s_sleep(1);
        if ((++sp & 255u) == 0u) { if (xb_ld(&bar[XB_TMO])) break; if (sp > XB_SPIN_CAP) { atomicAdd(&bar[XB_TMO], 1u); break; } }
    }
    nloc = mine > 0u ? mine : 1u; nx = cnt > 0u ? cnt : 1u;
}
__device__ __forceinline__ void xcd_barrier(const XcdBarrier& b) {
    asm volatile("s_waitcnt vmcnt(0)" ::: "memory");
    __syncthreads();
    if (threadIdx.x == 0) {
        unsigned* bar = b.bar;
        __builtin_amdgcn_s_waitcnt(0);
        unsigned nloc = b.st[0], nx = b.st[1];
        if (nloc == 0u) { xcd_barrier_complete(bar, b.x, nloc, nx); b.st[0] = nloc; b.st[1] = nx; }
        const unsigned old = xb_add(&bar[XB_XSUB(b.x)], 1u);
        const unsigned gen = old / nloc;
        if (old + 1u == (gen + 1u) * nloc) {
            __builtin_amdgcn_fence(__ATOMIC_RELEASE, "agent");
            asm volatile("s_waitcnt vmcnt(0)" ::: "memory");
            const unsigned og = xb_add(&bar[XB_TOP], 1u);
            const unsigned tg = og / nx;
            if (og + 1u == (tg + 1u) * nx) xb_add(&bar[XB_TOPGEN], 1u);
            else XB_SPIN(xb_ld(&bar[XB_TOPGEN]) == tg, bar);
            __builtin_amdgcn_fence(__ATOMIC_ACQUIRE, "agent");
            xb_add(&bar[XB_XGEN(b.x)], 1u);
            asm volatile("s_waitcnt vmcnt(0)" ::: "memory");
        } else {
            XB_SPIN(xb_ld(&bar[XB_XGEN(b.x)]) == gen, bar);
            __builtin_amdgcn_fence(__ATOMIC_ACQUIRE, "agent");
            asm volatile("s_waitcnt vmcnt(0)" ::: "memory");
        }
    }
    __syncthreads();
}

namespace pg8 {
#ifndef MK_SP2
#define MK_SP2 true
#endif
#ifndef MK_ALIGN
#define MK_ALIGN true
#endif
constexpr bool GEMM_SP2 = MK_SP2, GEMM_ALIGN = MK_ALIGN;
constexpr int BM = 256, BK = 64, HALF = 128, HTB = HALF * BK * 2, STAGE_BYTES = 8 * HTB, NXCD = 8, WGM = 8;
__device__ __forceinline__ int lds_byte(int r, int c) { const int st = (r >> 4) * 2 + (c >> 5), rr = r & 15, cc = c & 31, ob = rr * 64 + cc * 2; return st * 1024 + (ob ^ (((ob >> 9) & 1) << 5)); }
__device__ __forceinline__ void stage_rc(int b, int& R, int& C) { const int st = b / 1024, sb = b % 1024, swz = sb ^ (((sb >> 9) & 1) << 5); R = (st >> 1) * 16 + swz / 64; C = (st & 1) * 32 + (swz % 64) / 2; }
__device__ __forceinline__ int perm32(int rho) { const int n = rho >> 4, i = rho & 15; return 8 * (i >> 2) + 4 * n + (i & 3); }
struct Unit { int pm, pn; };
struct Gemm { const bf16_t* A; const bf16_t* Bt; int M, N, K, lda, ldb; };
struct StaticOrder {
    int nM, nN, nwg, G, c;
    __device__ void init(int M, int N, int G_, int c_) { nM = M / BM; nN = N / BM; nwg = nM * nN; G = G_; c = c_; }
    __device__ bool next(int i, Unit& u) const {
        const long L = (long)i * G + c; if (L >= nwg) return false;
        int wgid = (int)L; { const int q = nwg / NXCD, r = nwg % NXCD, xcd = wgid % NXCD, off = wgid / NXCD; wgid = (xcd < r ? xcd * (q + 1) : r * (q + 1) + (xcd - r) * q) + off; }
        const int nig = WGM * nN, gid = wgid / nig, fm = gid * WGM, gsz = (nM - fm) < WGM ? (nM - fm) : WGM;
        u.pm = fm + ((wgid % nig) % gsz); u.pn = (wgid % nig) / gsz; return true;
    }
};
template <class Epi>
__device__ __forceinline__ void gemm_phase(LAS unsigned char* lds, const Gemm g, const StaticOrder& S, const Epi& E, const int tid) {
    const int wid = __builtin_amdgcn_readfirstlane(tid >> 6), lane = tid & 63, wr = wid >> 2, wc = wid & 3, fr = lane & 15, fq = lane >> 4;
    const int K = g.K, nt = K / BK;
    unsigned voffA[2], voffB[2];
#pragma unroll
    for (int i = 0; i < 2; ++i) { int R, C; stage_rc(tid * 16 + i * 8192, R, C); const int Rb = Epi::PERM ? ((R & ~31) + perm32(R & 31)) : R;
        voffA[i] = (unsigned)(R * g.lda + C) * 2u; voffB[i] = (unsigned)(Rb * g.ldb + C) * 2u; }
    const size_t kstep = (size_t)(BK * 2);
    const size_t hA = (size_t)HALF * g.lda * 2, hB = (size_t)HALF * g.ldb * 2;
    const size_t tA = 2 * hA, tB = 2 * hB;
    const unsigned ldsw = (unsigned)wid * 1024u;
    const int aoff = lds_byte(wr * 64 + fr, fq * 8), boff = lds_byte(wc * 32 + fr, fq * 8);
#define PG8_SA(b, h) (((b) * 2 + (h)) * HTB)
#define PG8_SB(b, h) ((4 + (b) * 2 + (h)) * HTB)
#define PG8_STAGE(bufoff, gbase, voff) do { _Pragma("unroll") for (int _i = 0; _i < 2; ++_i) \
        __builtin_amdgcn_global_load_lds((const unsigned*)((const char*)(gbase) + (voff)[_i]), (LAS unsigned*)(lds + (bufoff) + ldsw + _i * 8192), 16, 0, 0); } while (0)
#define PG8_LDA(dst, b, h) do { _Pragma("unroll") for (int m = 0; m < 4; ++m) _Pragma("unroll") for (int k = 0; k < 2; ++k) dst[m][k] = *(const LAS bf16x8*)(lds + PG8_SA(b, h) + aoff + m * 2048 + k * 1024); } while (0)
#define PG8_LDB(dst, b, h) do { _Pragma("unroll") for (int n = 0; n < 2; ++n) _Pragma("unroll") for (int k = 0; k < 2; ++k) dst[n][k] = *(const LAS bf16x8*)(lds + PG8_SB(b, h) + boff + n * 2048 + k * 1024); } while (0)
#define PG8_MMA(ai, bj, At, Bt) do { __builtin_amdgcn_s_setprio(1); _Pragma("unroll") for (int m = 0; m < 4; ++m) _Pragma("unroll") for (int n = 0; n < 2; ++n) _Pragma("unroll") for (int k = 0; k < 2; ++k) \
        acc[ai][bj][m][n] = __builtin_amdgcn_mfma_f32_16x16x32_bf16(Bt[n][k], At[m][k], acc[ai][bj][m][n], 0, 0, 0); __builtin_amdgcn_s_setprio(0); } while (0)
#define PG8_WAIT_V(n) asm volatile("s_waitcnt vmcnt(" #n ")" ::: "memory")
#define PG8_WAIT_L(n) asm volatile("s_waitcnt lgkmcnt(" #n ")" ::: "memory")
#define PG8_BAR __builtin_amdgcn_s_barrier()
#define PG8_SCHED __builtin_amdgcn_sched_barrier(0)
    Unit cur, nxt; int ui = 0;
    if (!S.next(0, cur)) return;
    f32x4 acc[2][2][4][2];
#pragma unroll
    for (int a = 0; a < 2; ++a)
#pragma unroll
        for (int b = 0; b < 2; ++b)
#pragma unroll
            for (int m = 0; m < 4; ++m)
#pragma unroll
                for (int n = 0; n < 2; ++n) acc[a][b][m][n] = (f32x4){0.f, 0.f, 0.f, 0.f};
    bf16x8 At[4][2], B0[2][2], B1[2][2];
    const char* cA = (const char*)g.A + (size_t)cur.pm * tA; const char* cB = (const char*)g.Bt + (size_t)cur.pn * tB;
    if constexpr (GEMM_SP2) {
        PG8_STAGE(PG8_SB(0, 0), cB, voffB); PG8_STAGE(PG8_SB(0, 1), cB + hB, voffB); PG8_STAGE(PG8_SA(0, 0), cA, voffA); PG8_STAGE(PG8_SA(0, 1), cA + hA, voffA);
        if (wr == 1) PG8_BAR;
        PG8_WAIT_V(2); PG8_BAR;
        PG8_STAGE(PG8_SB(1, 0), cB + kstep, voffB); PG8_STAGE(PG8_SA(1, 0), cA + kstep, voffA); PG8_STAGE(PG8_SB(1, 1), cB + hB + kstep, voffB);
        PG8_WAIT_V(6); PG8_BAR;
    } else {
    PG8_STAGE(PG8_SB(0, 0), cB, voffB); PG8_STAGE(PG8_SA(0, 0), cA, voffA); PG8_STAGE(PG8_SB(0, 1), cB + hB, voffB); PG8_STAGE(PG8_SA(0, 1), cA + hA, voffA);
    if (wr == 1) PG8_BAR;
    PG8_WAIT_V(4); PG8_BAR;
    PG8_STAGE(PG8_SB(1, 0), cB + kstep, voffB); PG8_STAGE(PG8_SA(1, 0), cA + kstep, voffA); PG8_STAGE(PG8_SB(1, 1), cB + hB + kstep, voffB);
    PG8_WAIT_V(6); PG8_BAR;
    }
    for (;;) {
        const bool has_next = S.next(ui + 1, nxt);
        const char* nA = has_next ? (const char*)g.A + (size_t)nxt.pm * tA : cA; const char* nB = has_next ? (const char*)g.Bt + (size_t)nxt.pn * tB : cB;
        for (int t = 0; t < nt; t += 2) {
            const bool last = (t == nt - 2);
            const char* a1 = cA + (size_t)(t + 1) * kstep;
            const char* a2 = last ? nA : cA + (size_t)(t + 2) * kstep; const char* b2 = last ? nB : cB + (size_t)(t + 2) * kstep;
            const char* a3 = a2 + kstep; const char* b3 = b2 + kstep;
            if constexpr (Epi::KHOOK) { if (t == 8 || t == 24) E.khook(acc, cur, t, wr, wc, fr, fq); }
            if constexpr (GEMM_SP2) {
            PG8_LDB(B0, 0, 0); PG8_LDB(B1, 0, 1); PG8_SCHED; PG8_LDA(At, 0, 0); PG8_STAGE(PG8_SA(1, 1), a1 + hA, voffA);
            PG8_WAIT_V(8); PG8_WAIT_L(0); PG8_BAR; PG8_MMA(0, 0, At, B0); PG8_MMA(0, 1, At, B1); PG8_BAR; PG8_SCHED;
            PG8_LDA(At, 0, 1); PG8_STAGE(PG8_SB(0, 0), b2, voffB); PG8_STAGE(PG8_SB(0, 1), b2 + hB, voffB); PG8_STAGE(PG8_SA(0, 0), a2, voffA);
            PG8_WAIT_V(8); PG8_WAIT_L(0); PG8_BAR; PG8_MMA(1, 0, At, B0); PG8_MMA(1, 1, At, B1); PG8_BAR; PG8_SCHED;
            PG8_LDB(B0, 1, 0); PG8_LDB(B1, 1, 1); PG8_SCHED; PG8_LDA(At, 1, 0); PG8_STAGE(PG8_SA(0, 1), a2 + hA, voffA);
            PG8_WAIT_V(8); PG8_WAIT_L(0); PG8_BAR; PG8_MMA(0, 0, At, B0); PG8_MMA(0, 1, At, B1); PG8_BAR; PG8_SCHED;
            PG8_LDA(At, 1, 1); PG8_STAGE(PG8_SB(1, 0), b3, voffB); PG8_STAGE(PG8_SB(1, 1), b3 + hB, voffB); PG8_STAGE(PG8_SA(1, 0), a3, voffA);
            PG8_WAIT_V(8); PG8_WAIT_L(0); PG8_BAR; PG8_MMA(1, 0, At, B0); PG8_MMA(1, 1, At, B1); PG8_BAR; PG8_SCHED;
            } else {
            PG8_LDB(B0, 0, 0); PG8_SCHED; PG8_LDA(At, 0, 0); PG8_STAGE(PG8_SA(1, 1), a1 + hA, voffA);
            PG8_WAIT_L(8); PG8_BAR; PG8_WAIT_L(0); PG8_MMA(0, 0, At, B0); PG8_BAR; PG8_SCHED;
            PG8_LDB(B1, 0, 1); PG8_STAGE(PG8_SB(0, 0), b2, voffB);
            PG8_BAR; PG8_WAIT_L(0); PG8_MMA(0, 1, At, B1); PG8_BAR;
            PG8_LDA(At, 0, 1); PG8_STAGE(PG8_SA(0, 0), a2, voffA);
            PG8_BAR; PG8_WAIT_L(0); PG8_MMA(1, 0, At, B0); PG8_BAR; PG8_SCHED;
            PG8_STAGE(PG8_SB(0, 1), b2 + hB, voffB);
            PG8_WAIT_V(6); PG8_BAR; PG8_MMA(1, 1, At, B1); PG8_BAR;
            PG8_LDB(B0, 1, 0); PG8_SCHED; PG8_LDA(At, 1, 0); PG8_STAGE(PG8_SA(0, 1), a2 + hA, voffA);
            PG8_WAIT_L(8); PG8_BAR; PG8_WAIT_L(0); PG8_MMA(0, 0, At, B0); PG8_BAR; PG8_SCHED;
            PG8_LDB(B1, 1, 1); PG8_STAGE(PG8_SB(1, 0), b3, voffB);
            PG8_BAR; PG8_WAIT_L(0); PG8_MMA(0, 1, At, B1); PG8_BAR;
            PG8_LDA(At, 1, 1); PG8_STAGE(PG8_SA(1, 0), a3, voffA);
            PG8_BAR; PG8_WAIT_L(0); PG8_MMA(1, 0, At, B0); PG8_BAR; PG8_SCHED;
            PG8_STAGE(PG8_SB(1, 1), b3 + hB, voffB);
            PG8_WAIT_V(6); PG8_BAR; PG8_MMA(1, 1, At, B1); PG8_BAR;
            }
        }
        if constexpr (GEMM_ALIGN) { if (wr == 0) PG8_BAR; }
        E(acc, cur, wr, wc, fr, fq);
        if (!has_next) break;
#pragma unroll
        for (int a = 0; a < 2; ++a)
#pragma unroll
            for (int b = 0; b < 2; ++b)
#pragma unroll
                for (int m = 0; m < 4; ++m)
#pragma unroll
                    for (int n = 0; n < 2; ++n) acc[a][b][m][n] = (f32x4){0.f, 0.f, 0.f, 0.f};
        cur = nxt; cA = nA; cB = nB; ++ui;
        if constexpr (GEMM_ALIGN) { if (wr == 1) PG8_BAR; }
    }
    PG8_WAIT_V(0);
    if constexpr (!GEMM_ALIGN) { if (wr == 0) PG8_BAR; }
    PG8_BAR;
#undef PG8_SA
#undef PG8_SB
#undef PG8_STAGE
#undef PG8_LDA
#undef PG8_LDB
#undef PG8_MMA
#undef PG8_WAIT_V
#undef PG8_WAIT_L
#undef PG8_BAR
#undef PG8_SCHED
}
}
using pg8::Unit;

#define EPI_FOR_ROWS  _Pragma("unroll") for (int ai = 0; ai < 2; ++ai) _Pragma("unroll") for (int m = 0; m < 4; ++m)
#define EPI_FOR_COLS  _Pragma("unroll") for (int bj = 0; bj < 2; ++bj) _Pragma("unroll") for (int n = 0; n < 2; ++n)
#define EPI_FOR_BJ    _Pragma("unroll") for (int bj = 0; bj < 2; ++bj)
#define EPI_ROW (u.pm * 256 + ai * 128 + wr * 64 + m * 16 + fr)
#define EPI_COL (u.pn * 256 + bj * 128 + wc * 32 + n * 16 + 4 * fq)
#define EPI_COL8 (u.pn * 256 + bj * 128 + wc * 32 + 8 * fq)
typedef f32x4 AccT[2][2][4][2];

__device__ __forceinline__ void st_bf4(bf16_t* p, f32x4 v) { u32x2 w; w.x = pk2(v[0], v[1]); w.y = pk2(v[2], v[3]); *(u32x2*)p = w; }
__device__ __forceinline__ void st_bf8(bf16_t* p, f32x4 v0, f32x4 v1) { u32x4 w; w.x = pk2(v0[0], v0[1]); w.y = pk2(v0[2], v0[3]); w.z = pk2(v1[0], v1[1]); w.w = pk2(v1[2], v1[3]); *(u32x4*)p = w; }
__device__ __forceinline__ f32x4 ld_bf4(const bf16_t* p) { const u32x2 w = *(const u32x2*)p; return (f32x4){bflo(w.x), bfhi(w.x), bflo(w.y), bfhi(w.y)}; }
__device__ __forceinline__ f32x4 bf4lo(u32x4 w) { return (f32x4){bflo(w.x), bfhi(w.x), bflo(w.y), bfhi(w.y)}; }
__device__ __forceinline__ f32x4 bf4hi(u32x4 w) { return (f32x4){bflo(w.z), bfhi(w.z), bflo(w.w), bfhi(w.w)}; }

struct EpiStore {
    static constexpr bool KHOOK = false, PERM = true;
    bf16_t* O; int ldc;
    __device__ __forceinline__ void operator()(const AccT& acc, const Unit& u, int wr, int wc, int fr, int fq) const {
        EPI_FOR_ROWS { bf16_t* rp = O + (size_t)EPI_ROW * ldc; EPI_FOR_BJ st_bf8(rp + EPI_COL8, acc[ai][bj][m][0], acc[ai][bj][m][1]); }
    }
    __device__ __forceinline__ void khook(AccT&, const Unit&, int, int, int, int, int) const {}
};
struct EpiSqRelu {
    static constexpr bool KHOOK = false, PERM = true;
    bf16_t* O; int ldc;
    __device__ __forceinline__ void operator()(const AccT& acc, const Unit& u, int wr, int wc, int fr, int fq) const {
        EPI_FOR_ROWS { bf16_t* rp = O + (size_t)EPI_ROW * ldc; EPI_FOR_BJ { f32x4 v0 = acc[ai][bj][m][0], v1 = acc[ai][bj][m][1];
#pragma unroll
            for (int j = 0; j < 4; ++j) { const float r0 = fmaxf(v0[j], 0.f), r1 = fmaxf(v1[j], 0.f); v0[j] = r0 * r0; v1[j] = r1 * r1; }
            st_bf8(rp + EPI_COL8, v0, v1); } }
    }
    __device__ __forceinline__ void khook(AccT&, const Unit&, int, int, int, int, int) const {}
};
struct EpiSigmoid {
    static constexpr bool KHOOK = false, PERM = true;
    bf16_t* O; int ldc; const float* bias;
    __device__ __forceinline__ void operator()(const AccT& acc, const Unit& u, int wr, int wc, int fr, int fq) const {
        f32x4 bv[2][2];
        EPI_FOR_BJ { const int c = EPI_COL8; bv[bj][0] = *(const f32x4*)(bias + c); bv[bj][1] = *(const f32x4*)(bias + c + 4); }
        EPI_FOR_ROWS { bf16_t* rp = O + (size_t)EPI_ROW * ldc; EPI_FOR_BJ { f32x4 v0 = acc[ai][bj][m][0] + bv[bj][0], v1 = acc[ai][bj][m][1] + bv[bj][1];
#pragma unroll
            for (int j = 0; j < 4; ++j) { v0[j] = sigmoidf_(v0[j]); v1[j] = sigmoidf_(v1[j]); }
            st_bf8(rp + EPI_COL8, v0, v1); } }
    }
    __device__ __forceinline__ void khook(AccT&, const Unit&, int, int, int, int, int) const {}
};
struct EpiGlu {
    static constexpr bool KHOOK = false, PERM = true;
    bf16_t* O; int ldc; int ocol0; const bf16_t* Yin; int ldy; const float* bias;
    __device__ __forceinline__ void operator()(const AccT& acc, const Unit& u, int wr, int wc, int fr, int fq) const {
#pragma unroll
        for (int ai = 0; ai < 2; ++ai) {
            u32x4 yq[4][2];
#pragma unroll
            for (int m = 0; m < 4; ++m) { const size_t row = (size_t)EPI_ROW; EPI_FOR_BJ yq[m][bj] = *(const u32x4*)(Yin + row * ldy + EPI_COL8); }
            __builtin_amdgcn_sched_barrier(0);
#pragma unroll
            for (int m = 0; m < 4; ++m) { const size_t row = (size_t)EPI_ROW; EPI_FOR_BJ { const int c = EPI_COL8; const u32x4 w = yq[m][bj]; const f32x4 y0 = bf4lo(w), y1 = bf4hi(w);
                f32x4 v0 = acc[ai][bj][m][0] + *(const f32x4*)(bias + c), v1 = acc[ai][bj][m][1] + *(const f32x4*)(bias + c + 4);
#pragma unroll
                for (int j = 0; j < 4; ++j) { v0[j] = y0[j] * sigmoidf_(v0[j]); v1[j] = y1[j] * sigmoidf_(v1[j]); }
                st_bf8(O + row * ldc + ocol0 + c, v0, v1); } }
            __builtin_amdgcn_sched_barrier(0);
        }
    }
    __device__ __forceinline__ void khook(AccT&, const Unit&, int, int, int, int, int) const {}
};
struct EpiMerge {
    static constexpr bool KHOOK = true, PERM = true;
    bf16_t* O; const bf16_t* G;
    __device__ __forceinline__ void khook(AccT& acc, const Unit& u, int t, int wr, int wc, int fr, int fq) const {
        unsigned goff = (unsigned)((u.pm * 256 + wr * 64 + fr) * 3072 + u.pn * 256 + wc * 32 + 8 * fq + ((t == 8) ? 0 : 1024)) * 2u;
        asm volatile("" : "+v"(goff));
        const char* gb = (const char*)G;
#pragma unroll
        for (int ai = 0; ai < 2; ++ai) {
            u32x4 q0[4][2], q1[4][2];
#pragma unroll
            for (int m = 0; m < 4; ++m) EPI_FOR_BJ { const unsigned o = goff + (unsigned)(((ai * 128 + m * 16) * 3072 + bj * 128) * 2);
                q0[m][bj] = *(const u32x4*)(gb + o); q1[m][bj] = *(const u32x4*)(gb + o + 2048); }
            __builtin_amdgcn_sched_barrier(0);
#pragma unroll
            for (int m = 0; m < 4; ++m) EPI_FOR_BJ { const u32x4 a = q0[m][bj], b = q1[m][bj];
                const f32x4 g00 = bf4lo(a), g01 = bf4hi(a), g10 = bf4lo(b), g11 = bf4hi(b);
#pragma unroll
                for (int j = 0; j < 4; ++j) { acc[ai][bj][m][0][j] *= g00[j] * __builtin_amdgcn_rcpf(g10[j]); acc[ai][bj][m][1][j] *= g01[j] * __builtin_amdgcn_rcpf(g11[j]); } }
            __builtin_amdgcn_sched_barrier(0);
        }
    }
    __device__ __forceinline__ void operator()(const AccT& acc, const Unit& u, int wr, int wc, int fr, int fq) const {
        u32x4 gq[2][4][2];
        EPI_FOR_ROWS { const size_t row = (size_t)EPI_ROW; EPI_FOR_BJ gq[ai][m][bj] = *(const u32x4*)(G + row * 3072 + 2048 + EPI_COL8); }
        __builtin_amdgcn_sched_barrier(0);
        EPI_FOR_ROWS { const size_t row = (size_t)EPI_ROW; EPI_FOR_BJ { const u32x4 w = gq[ai][m][bj];
            st_bf8(O + row * 1024 + EPI_COL8, acc[ai][bj][m][0] * bf4lo(w), acc[ai][bj][m][1] * bf4hi(w)); } }
    }
};
struct EpiResid {
    static constexpr bool KHOOK = false, PERM = true;
    bf16_t* C; const bf16_t* X;
    __device__ __forceinline__ void operator()(const AccT& acc, const Unit& u, int wr, int wc, int fr, int fq) const {
        u32x4 xq[2][4][2];
        EPI_FOR_ROWS { const size_t row = (size_t)EPI_ROW; EPI_FOR_BJ xq[ai][m][bj] = *(const u32x4*)(X + row * 1024 + EPI_COL8); }
        __builtin_amdgcn_sched_barrier(0);
        EPI_FOR_ROWS { const size_t row = (size_t)EPI_ROW; EPI_FOR_BJ { const u32x4 w = xq[ai][m][bj];
            st_bf8(C + row * 1024 + EPI_COL8, bf4lo(w) * DN_ALPHA + acc[ai][bj][m][0], bf4hi(w) * DN_ALPHA + acc[ai][bj][m][1]); } }
    }
    __device__ __forceinline__ void khook(AccT&, const Unit&, int, int, int, int, int) const {}
};

template <class Epi>
__device__ __forceinline__ void run_gemm(const int tid, const int bid, const int gsz, unsigned char* smem, const bf16_t* A, int lda, const bf16_t* Bt, int ldb, int N, int K, const Epi& E) {
    pg8::Gemm g; g.A = A; g.Bt = Bt; g.M = T_; g.N = N; g.K = K; g.lda = lda; g.ldb = ldb;
    pg8::StaticOrder S; S.init(T_, N, gsz, bid);
    pg8::gemm_phase<Epi>((LAS unsigned char*)smem, g, S, E, tid);
}

__device__ __forceinline__ void transpose_cvt(const int tid, const int bid, const int gsz, const float* __restrict__ src, int K, int N, bf16_t* __restrict__ dst, float* tile) {
    const int tn = N / 64, ntile = (K / 64) * tn;
    for (int t = bid; t < ntile; t += gsz) {
        const int k0 = (t / tn) * 64, n0 = (t % tn) * 64;
#pragma unroll
        for (int r = 0; r < 2; ++r) { const int i = (tid >> 4) + 32 * r, j = (tid & 15) * 4;
            const f32x4 v = *(const f32x4*)(src + (size_t)(k0 + i) * N + n0 + j);
            tile[i * 65 + j] = v[0]; tile[i * 65 + j + 1] = v[1]; tile[i * 65 + j + 2] = v[2]; tile[i * 65 + j + 3] = v[3]; }
        __syncthreads();
        const int jn = tid >> 3, i8 = (tid & 7) * 8;
        u32x4 w;
        w.x = pk2(tile[(i8 + 0) * 65 + jn], tile[(i8 + 1) * 65 + jn]); w.y = pk2(tile[(i8 + 2) * 65 + jn], tile[(i8 + 3) * 65 + jn]);
        w.z = pk2(tile[(i8 + 4) * 65 + jn], tile[(i8 + 5) * 65 + jn]); w.w = pk2(tile[(i8 + 6) * 65 + jn], tile[(i8 + 7) * 65 + jn]);
        *(u32x4*)(dst + (size_t)(n0 + jn) * K + k0 + i8) = w;
        __syncthreads();
    }
}
__device__ __forceinline__ void phase_convert(const int tid, const int bid, const int gsz, const Params& p, int l, unsigned char* smem, const int parts) {
    float* tile = (float*)smem;
    bf16_t* W = (bf16_t*)(p.ws + W_OFF + (size_t)l * 40 * MiB);
    if (parts & 1) transpose_cvt(tid, bid, gsz, p.w_in + (size_t)l * 1024 * PTOT, 1024, PTOT, W + WT_IN, tile);
    if (parts & 2) {
    transpose_cvt(tid, bid, gsz, p.c_w_glu + (size_t)l * 512 * 512, 512, 512, W + WT_GLU, tile);
    transpose_cvt(tid, bid, gsz, p.w_branch + (size_t)l * 2048 * 1024, 2048, 1024, W + WT_BR, tile);
    transpose_cvt(tid, bid, gsz, p.w_out + (size_t)l * 1024 * 1024, 1024, 1024, W + WT_OUT, tile);
    transpose_cvt(tid, bid, gsz, p.w_ff1 + (size_t)l * 1024 * 4096, 1024, 4096, W + WT_FF1, tile);
    transpose_cvt(tid, bid, gsz, p.w_ff2 + (size_t)l * 4096 * 1024, 4096, 1024, W + WT_FF2, tile);
    }
    if (l == 0 && (parts & 1)) {
        bf16_t* X = (bf16_t*)(p.ws + XBF_OFF);
        const size_t n4 = (size_t)T_ * D_ / 4;
        for (size_t i = (size_t)bid * 512 + tid; i < n4; i += (size_t)gsz * 512) {
            const f32x4 v = *(const f32x4*)(p.x + i * 4); st_bf4(X + i * 4, v); }
    }
}

__device__ __forceinline__ void phase_ln(const int tid, const int bid, const int gsz, const bf16_t* src, const float* gam, const float* bet, bf16_t* xbf, float* fout) {
    const int lane = tid & 63, wid = tid >> 6;
    f32x4 gv[4], bv[4];
#pragma unroll
    for (int j = 0; j < 4; ++j) { gv[j] = *(const f32x4*)(gam + lane * 4 + 256 * j); bv[j] = *(const f32x4*)(bet + lane * 4 + 256 * j); }
    for (int row = bid * 8 + wid; row < T_; row += gsz * 8) {
        const bf16_t* rp = src + (size_t)row * D_;
        f32x4 v[4]; float s = 0.f;
#pragma unroll
        for (int j = 0; j < 4; ++j) { v[j] = ld_bf4(rp + lane * 4 + 256 * j); s += (v[j][0] + v[j][1]) + (v[j][2] + v[j][3]); }
        const float mean = wave_sum(s) * (1.f / D_); float s2 = 0.f;
#pragma unroll
        for (int j = 0; j < 4; ++j) { v[j] = v[j] - mean; s2 += (v[j][0] * v[j][0] + v[j][1] * v[j][1]) + (v[j][2] * v[j][2] + v[j][3] * v[j][3]); }
        const float rstd = rsqrtf(wave_sum(s2) * (1.f / D_) + 1e-5f);
#pragma unroll
        for (int j = 0; j < 4; ++j) { const f32x4 o = v[j] * rstd * gv[j] + bv[j];
            st_bf4(xbf + (size_t)row * D_ + lane * 4 + 256 * j, o);
            if (fout) *(f32x4*)(fout + (size_t)row * D_ + lane * 4 + 256 * j) = o; }
    }
}

__device__ __forceinline__ int rwkv_gcol(int vi, int h) { return (vi < 24) ? ((vi >> 3) * 512 + h * 64 + (vi & 7) * 8) : (1536 + (vi - 24) * 8); }
__device__ __forceinline__ void prep_bar(unsigned* cnt, unsigned& gen, int lane) {
    gen += 4u;
    asm volatile("s_waitcnt lgkmcnt(0)" ::: "memory");
    if (lane == 0) __hip_atomic_fetch_add(cnt, 1u, __ATOMIC_RELAXED, __HIP_MEMORY_SCOPE_WORKGROUP);
    while (__hip_atomic_load(cnt, __ATOMIC_RELAXED, __HIP_MEMORY_SCOPE_WORKGROUP) < gen) __builtin_amdgcn_s_sleep(1);
    asm volatile("" ::: "memory");
}
__device__ __forceinline__ void rwkv_item(const int tid, const Params& p, int l, int b, int h, unsigned char* smem) {
    const int lane = tid & 63, wid = tid >> 6, quad = lane >> 4, l15 = lane & 15;
    float* R2 = (float*)smem; float* K2 = R2 + 4096; float* V2 = K2 + 4096; float* W2 = V2 + 4096; float* NA2 = W2 + 4096; float* NB2 = NA2 + 4096;
    float* G2 = NB2 + 4096; float* O2 = G2 + 4096; float* A_ = O2 + 4096; float* RK2 = A_ + 2048;
    bf16_t* ZL = (bf16_t*)(RK2 + 64);
    float* MU = (float*)(ZL + 32 * 264);
    unsigned* SBAR = (unsigned*)(MU + 448);
    const bf16_t* P = (const bf16_t*)(p.ws + P_OFF) + (size_t)b * S_ * PW;
    bf16_t* Y = (bf16_t*)p.out + (size_t)b * S_ * 2048;
    for (int c = tid; c < 448; c += 512) { const int vi = c >> 3; MU[c] = p.a_shift[l * 1792 + rwkv_gcol(vi, h) + (c & 7)]; }
    if (tid == 0) SBAR[0] = 0u;
    __syncthreads();
    if (tid < 256) {
        const int sv = (tid >> 3) & 31, sj = tid & 7;
        f32x2 SA[4], SB[4];
#pragma unroll
        for (int i = 0; i < 4; ++i) { SA[i] = (f32x2){0.f, 0.f}; SB[i] = SA[i]; }
        __syncthreads();
        for (int ch = 0; ch < S_ / 32; ++ch) {
            const int cb = (ch & 1) * 2048;
            const float* Rc = R2 + cb; const float* Kc = K2 + cb; const float* Vc = V2 + cb; const float* Wc = W2 + cb; const float* NAc = NA2 + cb; const float* NBc = NB2 + cb;
            float* Oc = O2 + cb;
            f32x4 cna0, cna1, cw0, cw1, cnb0, cnb1, ckt0, ckt1, cr0, cr1; float cva, cvb;
#define RW_LOAD(tt_) do { const int o_ = (tt_) * 64 + sj * 8; \
            cna0 = *(const f32x4*)(NAc + o_); cna1 = *(const f32x4*)(NAc + o_ + 4); cw0 = *(const f32x4*)(Wc + o_); cw1 = *(const f32x4*)(Wc + o_ + 4); \
            cnb0 = *(const f32x4*)(NBc + o_); cnb1 = *(const f32x4*)(NBc + o_ + 4); ckt0 = *(const f32x4*)(Kc + o_); ckt1 = *(const f32x4*)(Kc + o_ + 4); \
            cr0 = *(const f32x4*)(Rc + o_); cr1 = *(const f32x4*)(Rc + o_ + 4); cva = Vc[(tt_) * 64 + sv]; cvb = Vc[(tt_) * 64 + sv + 32]; } while (0)
            RW_LOAD(0);
            float keepA = 0.f, keepB = 0.f;
#pragma unroll 32
            for (int tt = 0; tt < 32; ++tt) {
                const f32x4 na0 = cna0, na1 = cna1, w0 = cw0, w1 = cw1, nb0 = cnb0, nb1 = cnb1, kt0 = ckt0, kt1 = ckt1, r0 = cr0, r1 = cr1; const float va = cva, vb = cvb;
                { const int tn = (tt + 1) & 31; RW_LOAD(tn); }
                const f32x2 n0 = {na0[0], na0[1]}, n1 = {na0[2], na0[3]}, n2 = {na1[0], na1[1]}, n3 = {na1[2], na1[3]};
                f32x2 pa = SA[0] * n0; pa = SA[1] * n1 + pa; pa = SA[2] * n2 + pa; pa = SA[3] * n3 + pa;
                f32x2 pb = SB[0] * n0; pb = SB[1] * n1 + pb; pb = SB[2] * n2 + pb; pb = SB[3] * n3 + pb;
                float sa = pa[0] + pa[1], sb = pb[0] + pb[1];
                sa = sum8(sa); sb = sum8(sb);
                const f32x2 wv[4] = {{w0[0], w0[1]}, {w0[2], w0[3]}, {w1[0], w1[1]}, {w1[2], w1[3]}};
                const f32x2 nbv[4] = {{nb0[0], nb0[1]}, {nb0[2], nb0[3]}, {nb1[0], nb1[1]}, {nb1[2], nb1[3]}};
                const f32x2 ktv[4] = {{kt0[0], kt0[1]}, {kt0[2], kt0[3]}, {kt1[0], kt1[1]}, {kt1[2], kt1[3]}};
#pragma unroll
                for (int i = 0; i < 4; ++i) { SA[i] = SA[i] * wv[i] + (nbv[i] * sa + ktv[i] * va); SB[i] = SB[i] * wv[i] + (nbv[i] * sb + ktv[i] * vb); }
                const f32x2 q0 = {r0[0], r0[1]}, q1 = {r0[2], r0[3]}, q2 = {r1[0], r1[1]}, q3 = {r1[2], r1[3]};
                f32x2 oa = SA[0] * q0; oa = SA[1] * q1 + oa; oa = SA[2] * q2 + oa; oa = SA[3] * q3 + oa;
                f32x2 ob = SB[0] * q0; ob = SB[1] * q1 + ob; ob = SB[2] * q2 + ob; ob = SB[3] * q3 + ob;
                float xa = oa[0] + oa[1], xb = ob[0] + ob[1];
                xa = sum8(xa); xb = sum8(xb);
                keepA = (sj == (tt & 7)) ? xa : keepA; keepB = (sj == (tt & 7)) ? xb : keepB;
                if ((tt & 7) == 7) { Oc[(tt - 7 + sj) * 64 + sv] = keepA; Oc[(tt - 7 + sj) * 64 + sv + 32] = keepB; }
            }
#undef RW_LOAD
            __syncthreads();
        }
        __syncthreads();
    } else {
        const int st = tid - 256, pw = wid - 4;
        const int ocol = h * 64 + pw * 16 + l15;
        bf16x8 Bw[2], Ba[2], Bg[4];
#pragma unroll
        for (int ks = 0; ks < 2; ++ks)
#pragma unroll
            for (int jj = 0; jj < 8; ++jj) { const int k = ks * 32 + quad * 8 + jj;
                Bw[ks][jj] = (short)f2bf(p.a_w2[((size_t)l * 64 + k) * 512 + ocol]); Ba[ks][jj] = (short)f2bf(p.a_a2[((size_t)l * 64 + k) * 512 + ocol]); }
#pragma unroll
        for (int ks = 0; ks < 4; ++ks)
#pragma unroll
            for (int jj = 0; jj < 8; ++jj) { const int k = ks * 32 + quad * 8 + jj; Bg[ks][jj] = (short)f2bf(p.a_g2[((size_t)l * 128 + k) * 512 + ocol]); }
        const float w0v = p.a_w0[l * 512 + ocol], a0v = p.a_a0[l * 512 + ocol];
        const int ett0 = st >> 4, ecg = st & 15;
        const int hc = l * 512 + h * 64 + ecg * 4;
        const f32x4 kkc = *(const f32x4*)(p.a_kk + hc), kac = *(const f32x4*)(p.a_ka + hc), rkc = *(const f32x4*)(p.a_rk + hc),
                    lng = *(const f32x4*)(p.a_lnx_g + hc), lnb = *(const f32x4*)(p.a_lnx_b + hc);
        int svi, srg;
        if (st < 128) { srg = st >> 5; const int j = st & 31; svi = (j < 24) ? j : (8 + j); }
        else { const int u = st - 128; srg = u / 24; const int j = u - srg * 24; svi = (j < 8) ? (24 + j) : (32 + j); }
        const bool shact = st < 224;
        const float tr_a = (svi < 32) ? 2.0f : 1.0f, tr_b = (svi < 32) ? 2.8853900817779268f : 1.4426950408889634f, tr_c = (svi < 32) ? -1.0f : 0.0f;
        const bf16_t* sptr = P + (size_t)(srg * 8 - 1) * PW + rwkv_gcol(svi, h);
        u32x4 pr[9];
        unsigned gen = 0u;
#define RW_PREFETCH(t0n_) do { if (shact) { _Pragma("unroll") for (int j = 0; j < 9; ++j) { \
        pr[j] = ((t0n_) + srg * 8 - 1 + j >= 0) ? *(const u32x4*)(sptr + (size_t)((t0n_) + j) * PW) : (u32x4){0u, 0u, 0u, 0u}; } } } while (0)
#define RW_SHIFT(nb_) do { if (shact) { float* Rn_ = R2 + (nb_); float* Kn_ = K2 + (nb_); float* Vn_ = V2 + (nb_); const int vi = svi; \
        const f32x4 m0 = *(const f32x4*)(MU + vi * 8), m1 = *(const f32x4*)(MU + vi * 8 + 4); \
        _Pragma("unroll") for (int j = 1; j < 9; ++j) { const int tt = srg * 8 + j - 1; const u32x4 cw = pr[j], pw_ = pr[j - 1]; f32x4 z0, z1; \
            { const f32x4 c0 = {bflo(cw.x), bfhi(cw.x), bflo(cw.y), bfhi(cw.y)}, c1 = {bflo(cw.z), bfhi(cw.z), bflo(cw.w), bfhi(cw.w)}; \
              const f32x4 p0 = {bflo(pw_.x), bfhi(pw_.x), bflo(pw_.y), bfhi(pw_.y)}, p1 = {bflo(pw_.z), bfhi(pw_.z), bflo(pw_.w), bfhi(pw_.w)}; \
              z0 = c0 + m0 * (p0 - c0); z1 = c1 + m1 * (p1 - c1); } \
            if (vi < 24) { float* dst = ((vi < 8) ? Rn_ : (vi < 16) ? Kn_ : Vn_) + tt * 64 + (vi & 7) * 8; *(f32x4*)dst = z0; *(f32x4*)(dst + 4) = z1; } \
            else { if (st >= 128) { _Pragma("unroll") for (int q = 0; q < 4; ++q) { \
                       z0[q] = tr_a * __builtin_amdgcn_rcpf(1.0f + __builtin_amdgcn_exp2f(-tr_b * z0[q])) + tr_c; z1[q] = tr_a * __builtin_amdgcn_rcpf(1.0f + __builtin_amdgcn_exp2f(-tr_b * z1[q])) + tr_c; } } \
                   u32x4 o; o.x = pk2(z0[0], z0[1]); o.y = pk2(z0[2], z0[3]); o.z = pk2(z1[0], z1[1]); o.w = pk2(z1[2], z1[3]); \
                   *(u32x4*)(ZL + tt * 264 + (vi - 24) * 8) = o; } } } } while (0)
#define RW_LORA(nb_) do { _Pragma("unroll") for (int rt = 0; rt < 2; ++rt) { f32x4 cw = {0.f, 0.f, 0.f, 0.f}, ca = cw, cgv = cw; const bf16_t* zrow = ZL + (rt * 16 + l15) * 264 + quad * 8; \
        _Pragma("unroll") for (int ks = 0; ks < 2; ++ks) { const bf16x8 a = *(const bf16x8*)(zrow + ks * 32); cw = MFMA16(a, Bw[ks], cw); } \
        _Pragma("unroll") for (int ks = 0; ks < 2; ++ks) { const bf16x8 a = *(const bf16x8*)(zrow + 64 + ks * 32); ca = MFMA16(a, Ba[ks], ca); } \
        _Pragma("unroll") for (int ks = 0; ks < 4; ++ks) { const bf16x8 a = *(const bf16x8*)(zrow + 128 + ks * 32); cgv = MFMA16(a, Bg[ks], cgv); } \
        _Pragma("unroll") for (int jj = 0; jj < 4; ++jj) { const int tt = rt * 16 + quad * 4 + jj, col = pw * 16 + l15; \
            W2[(nb_) + tt * 64 + col] = __builtin_amdgcn_exp2f(-0.8750387749860377f * sigmoidf_(cw[jj] + w0v)); \
            A_[tt * 64 + col] = sigmoidf_(ca[jj] + a0v); G2[(nb_) + tt * 64 + col] = cgv[jj]; } } } while (0)
#define RW_ELEM(nb_) do { _Pragma("unroll") for (int it = 0; it < 2; ++it) { const int ett = ett0 + 16 * it; const int o = ett * 64 + ecg * 4; float* Kn_ = K2 + (nb_); \
        const f32x4 k4 = *(const f32x4*)(Kn_ + o), a4 = *(const f32x4*)(A_ + o), r4 = *(const f32x4*)(R2 + (nb_) + o); \
        const f32x4 kk = k4 * kkc; float ss = (kk[0] * kk[0] + kk[1] * kk[1]) + (kk[2] * kk[2] + kk[3] * kk[3]); ss = sum16(ss); \
        const float inv = __builtin_amdgcn_rsqf(fmaxf(ss, 1e-24f)); const f32x4 kkn = kk * inv; \
        *(f32x4*)(NA2 + (nb_) + o) = -kkn; *(f32x4*)(NB2 + (nb_) + o) = kkn * a4; \
        const f32x4 kt = k4 * (1.0f + (a4 - 1.0f) * kac); *(f32x4*)(Kn_ + o) = kt; \
        const f32x4 pr_ = r4 * kt * rkc; float rk = (pr_[0] + pr_[1]) + (pr_[2] + pr_[3]); rk = sum16(rk); \
        if (ecg == 0) RK2[((nb_) >> 6) + ett] = rk; } } while (0)
#define RW_OUT(cb_, t0_) do { _Pragma("unroll") for (int it = 0; it < 2; ++it) { const int ett = ett0 + 16 * it; const int o = ett * 64 + ecg * 4; \
        const f32x4 o4 = *(const f32x4*)(O2 + (cb_) + o); float s = (o4[0] + o4[1]) + (o4[2] + o4[3]); s = sum16(s); \
        const float mean = s * (1.f / 64.f); const f32x4 d = o4 - mean; \
        float q = (d[0] * d[0] + d[1] * d[1]) + (d[2] * d[2] + d[3] * d[3]); q = sum16(q); \
        const float rstd = rsqrtf(q * (1.f / 64.f) + 64e-5f); \
        const f32x4 v4 = *(const f32x4*)(V2 + (cb_) + o), g4 = *(const f32x4*)(G2 + (cb_) + o); const float rk = RK2[((cb_) >> 6) + ett]; \
        const f32x4 y = ((d * rstd) * lng + lnb + v4 * rk) * g4; \
        st_bf4(Y + (size_t)((t0_) + ett) * 2048 + h * 64 + ecg * 4, y); } } while (0)
        RW_PREFETCH(0);
        RW_SHIFT(0); RW_PREFETCH(32);
        prep_bar(SBAR, gen, lane);
        RW_LORA(0);
        prep_bar(SBAR, gen, lane);
        RW_ELEM(0);
        __syncthreads();
        for (int ch = 0; ch < S_ / 32; ++ch) {
            const int nb = ((ch + 1) & 1) * 2048;
            if (ch >= 1) RW_OUT(nb, (ch - 1) * 32);
            if (ch + 1 < S_ / 32) {
                prep_bar(SBAR, gen, lane);
                RW_SHIFT(nb);
                if (ch + 2 < S_ / 32) RW_PREFETCH((ch + 2) * 32);
                prep_bar(SBAR, gen, lane);
                RW_LORA(nb);
                prep_bar(SBAR, gen, lane);
                RW_ELEM(nb);
            }
            __syncthreads();
        }
        RW_OUT(2048, (S_ / 32 - 1) * 32);
        __syncthreads();
#undef RW_PREFETCH
#undef RW_SHIFT
#undef RW_LORA
#undef RW_ELEM
#undef RW_OUT
    }
}

__device__ __forceinline__ void ret_item(const int tid, const Params& p, int l, int b, int h, unsigned char* smem) {
    const int lane = tid & 63, wid = tid >> 6, quad = lane >> 4, l15 = lane & 15;
    bf16_t* Qs = (bf16_t*)smem;
    bf16_t* Ks = Qs + 32 * 136;
    bf16_t* Kt = Ks + 32 * 136;
    bf16_t* Vt = Kt + 128 * 40;
    bf16_t* Ss = Vt + 256 * 40;
    bf16_t* Rt = Ss + 32 * 40;
    float* Sp = (float*)(Rt + 256 * 136);
    float* Sf = Sp + 512;
    const bf16_t* P = (const bf16_t*)(p.ws + P_OFF) + (size_t)b * S_ * PW;
    bf16_t* Y = (bf16_t*)p.out + (size_t)b * S_ * 2048;
    const float lg2 = log2f(1.0f - exp2f(-5.0f - (float)h));
    const float gC = exp2f(lg2 * 32.f);
    for (int i = tid; i < 256 * 136 / 2; i += 512) ((unsigned*)Rt)[i] = 0u;
    f32x4 accR[8][2];
#pragma unroll
    for (int dt = 0; dt < 8; ++dt) { accR[dt][0] = (f32x4){0.f, 0.f, 0.f, 0.f}; accR[dt][1] = accR[dt][0]; }
    const int ltt = tid >> 4, dg = tid & 15;
    float cfr[4];
#pragma unroll
    for (int q = 0; q < 4; ++q) cfr[q] = exp2f(-(float)(dg + 16 * q) * (13.287712379549449f / 64.f)) * 0.15915494309189535f;
    const float decK = exp2f(lg2 * (float)(31 - ltt));
    const bf16_t* lrow = P + (size_t)ltt * PW + h * 128 + dg;
    const bf16_t* vrow = P + (size_t)ltt * PW + 2816 + h * 256 + dg;
    bf16_t pq1[4], pq2[4], pk1[4], pk2_[4], pv[16], pg[2][4][2];
    const bf16_t* grow = P + 3840 + h * 256 + wid * 32 + l15;
#pragma unroll
    for (int q = 0; q < 4; ++q) { pq1[q] = lrow[1792 + 16 * q]; pq2[q] = lrow[1792 + 64 + 16 * q]; pk1[q] = lrow[2304 + 16 * q]; pk2_[q] = lrow[2304 + 64 + 16 * q]; }
#pragma unroll
    for (int c = 0; c < 16; ++c) pv[c] = vrow[16 * c];
    __syncthreads();
    for (int ch = 0; ch < S_ / 32; ++ch) {
#pragma unroll
        for (int rt = 0; rt < 2; ++rt)
#pragma unroll
            for (int jj = 0; jj < 4; ++jj)
#pragma unroll
                for (int ct = 0; ct < 2; ++ct) pg[rt][jj][ct] = grow[(size_t)(ch * 32 + rt * 16 + quad * 4 + jj) * PW + ct * 16];

        const int t0 = ch * 32;
        {
            const int t = t0 + ltt;
#pragma unroll
            for (int q = 0; q < 4; ++q) {
                float rev = (float)t * cfr[q]; rev -= floorf(rev);
                const float cs = __builtin_amdgcn_cosf(rev), sn = __builtin_amdgcn_sinf(rev);
                const float q1 = bf2f(pq1[q]), q2 = bf2f(pq2[q]), k1 = bf2f(pk1[q]), k2 = bf2f(pk2_[q]);
                const float qa = q1 * cs - q2 * sn, qb = q2 * cs + q1 * sn;
                const float ka = (k1 * cs - k2 * sn) * 0.08838834764831845f, kb = (k2 * cs + k1 * sn) * 0.08838834764831845f;
                const int d = dg + 16 * q;
                Qs[ltt * 136 + d] = f2bf(qa); Qs[ltt * 136 + 64 + d] = f2bf(qb);
                Ks[ltt * 136 + d] = f2bf(ka); Ks[ltt * 136 + 64 + d] = f2bf(kb);
                Kt[d * 40 + ltt] = f2bf(ka * decK); Kt[(64 + d) * 40 + ltt] = f2bf(kb * decK);
            }
#pragma unroll
            for (int c = 0; c < 16; ++c) Vt[(dg + 16 * c) * 40 + ltt] = pv[c];
        }
        __syncthreads();
        if (ch + 1 < S_ / 32) {
            const size_t adv = (size_t)(t0 + 32) * PW;
#pragma unroll
            for (int q = 0; q < 4; ++q) { pq1[q] = lrow[adv + 1792 + 16 * q]; pq2[q] = lrow[adv + 1792 + 64 + 16 * q]; pk1[q] = lrow[adv + 2304 + 16 * q]; pk2_[q] = lrow[adv + 2304 + 64 + 16 * q]; }
#pragma unroll
            for (int c = 0; c < 16; ++c) pv[c] = vrow[adv + 16 * c];
        }
        if (wid < 4) {
            const int ri = wid & 1, cj = wid >> 1;
            f32x4 sc = {0.f, 0.f, 0.f, 0.f};
#pragma unroll
            for (int ks = 0; ks < 4; ++ks) { const bf16x8 a = *(const bf16x8*)(Qs + (ri * 16 + l15) * 136 + ks * 32 + quad * 8); const bf16x8 bb = *(const bf16x8*)(Ks + (cj * 16 + l15) * 136 + ks * 32 + quad * 8);
                sc = MFMA16(a, bb, sc); }
#pragma unroll
            for (int jj = 0; jj < 4; ++jj) { const int i = ri * 16 + quad * 4 + jj, j = cj * 16 + l15; const int rel = i - j;
                const float val = (rel >= 0) ? sc[jj] * exp2f(lg2 * (float)rel) : 0.f;
                Ss[i * 40 + j] = f2bf(val); }
        }
        f32x4 ao[2][2];
        ao[0][0] = (f32x4){0.f, 0.f, 0.f, 0.f}; ao[0][1] = ao[0][0]; ao[1][0] = ao[0][0]; ao[1][1] = ao[0][0];
#pragma unroll
        for (int ks = 0; ks < 4; ++ks) {
            const bf16x8 a0 = *(const bf16x8*)(Qs + l15 * 136 + ks * 32 + quad * 8), a1 = *(const bf16x8*)(Qs + (16 + l15) * 136 + ks * 32 + quad * 8);
#pragma unroll
            for (int ct = 0; ct < 2; ++ct) { const bf16x8 bb = *(const bf16x8*)(Rt + (wid * 32 + ct * 16 + l15) * 136 + ks * 32 + quad * 8);
                ao[0][ct] = MFMA16(a0, bb, ao[0][ct]); ao[1][ct] = MFMA16(a1, bb, ao[1][ct]); }
        }
#pragma unroll
        for (int rt = 0; rt < 2; ++rt)
#pragma unroll
            for (int jj = 0; jj < 4; ++jj) { const float s = exp2f(lg2 * (float)(rt * 16 + quad * 4 + jj + 1)); ao[rt][0][jj] *= s; ao[rt][1][jj] *= s; }
        __syncthreads();
        {
            bf16x8 bv[2];
#pragma unroll
            for (int ct = 0; ct < 2; ++ct) bv[ct] = *(const bf16x8*)(Vt + (wid * 32 + ct * 16 + l15) * 40 + quad * 8);
#pragma unroll
            for (int rt = 0; rt < 2; ++rt) { const bf16x8 a = *(const bf16x8*)(Ss + (rt * 16 + l15) * 40 + quad * 8);
                ao[rt][0] = MFMA16(a, bv[0], ao[rt][0]); ao[rt][1] = MFMA16(a, bv[1], ao[rt][1]); }
#pragma unroll
            for (int dt = 0; dt < 8; ++dt) { const bf16x8 a = *(const bf16x8*)(Kt + (dt * 16 + l15) * 40 + quad * 8);
#pragma unroll
                for (int ct = 0; ct < 2; ++ct) { accR[dt][ct] = accR[dt][ct] * gC; accR[dt][ct] = MFMA16(a, bv[ct], accR[dt][ct]);
                    st_bf4(Rt + (wid * 32 + ct * 16 + l15) * 136 + dt * 16 + quad * 4, accR[dt][ct]); } }
        }
#pragma unroll
        for (int rt = 0; rt < 2; ++rt)
#pragma unroll
            for (int jj = 0; jj < 4; ++jj) { const float x0 = ao[rt][0][jj], x1 = ao[rt][1][jj];
                float s = x0 + x1, ss = x0 * x0 + x1 * x1; s = sum16(s); ss = sum16(ss);
                if (l15 == 0) { const int i = rt * 16 + quad * 4 + jj; Sp[(i * 8 + wid) * 2] = s; Sp[(i * 8 + wid) * 2 + 1] = ss; } }
        __syncthreads();
        if (tid < 32) { float s = 0.f, ss = 0.f;
#pragma unroll
            for (int w = 0; w < 8; ++w) { s += Sp[(tid * 8 + w) * 2]; ss += Sp[(tid * 8 + w) * 2 + 1]; }
            const float mean = s * (1.f / 256.f); const float var = fmaxf(ss * (1.f / 256.f) - mean * mean, 0.f);
            Sf[tid * 2] = mean; Sf[tid * 2 + 1] = rsqrtf(var + 1e-5f); }
        __syncthreads();
#pragma unroll
        for (int rt = 0; rt < 2; ++rt)
#pragma unroll
            for (int jj = 0; jj < 4; ++jj) { const int i = rt * 16 + quad * 4 + jj; const float mean = Sf[i * 2], rstd = Sf[i * 2 + 1]; const size_t t = (size_t)(t0 + i);
#pragma unroll
                for (int ct = 0; ct < 2; ++ct) { const int e = wid * 32 + ct * 16 + l15;
                    const float g = bf2f(pg[rt][jj][ct]);
                    const float y = g * sigmoidf_(g) * ((ao[rt][ct][jj] - mean) * rstd);
                    Y[t * 2048 + 512 + h * 256 + e] = f2bf(y); } }
    }
}

__device__ __forceinline__ void s5_wave(const int tid, const Params& p, int l, int b, int g, unsigned char* wsm) {
    const int lane = tid & 63, quad = lane >> 4, l15 = lane & 15;
    float* U = (float*)wsm;
    bf16_t* X = (bf16_t*)(wsm + 2048);
    const bf16_t* P = (const bf16_t*)(p.ws + P_OFF) + (size_t)b * S_ * PW + 4864 + g * 16;
    bf16_t* Cp = (bf16_t*)(p.ws + CPRE_OFF) + (size_t)b * S_ * 512 + g * 16;
    const int lg = l * 32 + g;
    const float dt = expf(p.c_log_dt[lg]);
    const float lr = p.c_lam_re[lg * 64 + lane], li = p.c_lam_im[lg * 64 + lane];
    const float em1 = expm1f(lr * dt);
    const float th = li * dt;
    const float cth = cosf(th), sth = sinf(th), sh = sinf(0.5f * th);
    const float abr = (em1 + 1.0f) * cth, abi = (em1 + 1.0f) * sth;
    const float abr_m1 = em1 * cth - 2.0f * sh * sh;
    const float den = lr * lr + li * li;
    const float fre = (abr_m1 * lr + abi * li) / den, fim = (abi * lr - abr_m1 * li) / den;
    f32x2 bbr[8], bbi[8];
#pragma unroll
    for (int c4 = 0; c4 < 4; ++c4) { const f32x4 br = *(const f32x4*)(p.c_b_re + ((size_t)lg * 64 + lane) * 16 + c4 * 4), bi = *(const f32x4*)(p.c_b_im + ((size_t)lg * 64 + lane) * 16 + c4 * 4);
#pragma unroll
        for (int j = 0; j < 2; ++j) { bbr[c4 * 2 + j] = (f32x2){fre * br[2 * j] - fim * bi[2 * j], fre * br[2 * j + 1] - fim * bi[2 * j + 1]};
                                      bbi[c4 * 2 + j] = (f32x2){fre * bi[2 * j] + fim * br[2 * j], fre * bi[2 * j + 1] + fim * br[2 * j + 1]}; } }
    bf16x8 Cf[4];
#pragma unroll
    for (int ks = 0; ks < 4; ++ks)
#pragma unroll
        for (int jj = 0; jj < 8; ++jj) { const int k = (ks & 1) * 32 + quad * 8 + jj;
            const float v = (ks < 2) ? p.c_c_re[((size_t)lg * 16 + l15) * 64 + k] : -p.c_c_im[((size_t)lg * 16 + l15) * 64 + k];
            Cf[ks][jj] = (short)f2bf(v); }
    const float dsk = p.c_d[lg * 16 + l15];
    float xr = 0.f, xi = 0.f;
    const int utt = lane >> 1, uh = lane & 1;
    u32x4 upre = *(const u32x4*)(P + (size_t)utt * PW + uh * 8);
    for (int ch = 0; ch < S_ / 32; ++ch) {
        const int t0 = ch * 32;
        { const u32x4 w = upre;
          *(f32x4*)(U + utt * 16 + uh * 8) = (f32x4){bflo(w.x), bfhi(w.x), bflo(w.y), bfhi(w.y)};
          *(f32x4*)(U + utt * 16 + uh * 8 + 4) = (f32x4){bflo(w.z), bfhi(w.z), bflo(w.w), bfhi(w.w)}; }
        if (ch + 1 < S_ / 32) upre = *(const u32x4*)(P + (size_t)(t0 + 32 + utt) * PW + uh * 8);
        wave_lds_fence();
#pragma unroll 32
        for (int tt = 0; tt < 32; ++tt) {
            const f32x4 u0 = *(const f32x4*)(U + tt * 16), u1 = *(const f32x4*)(U + tt * 16 + 4), u2 = *(const f32x4*)(U + tt * 16 + 8), u3 = *(const f32x4*)(U + tt * 16 + 12);
            const f32x2 uu[8] = {{u0[0], u0[1]}, {u0[2], u0[3]}, {u1[0], u1[1]}, {u1[2], u1[3]}, {u2[0], u2[1]}, {u2[2], u2[3]}, {u3[0], u3[1]}, {u3[2], u3[3]}};
            f32x2 br2 = bbr[0] * uu[0], bi2 = bbi[0] * uu[0];
#pragma unroll
            for (int j = 1; j < 8; ++j) { br2 = br2 + bbr[j] * uu[j]; bi2 = bi2 + bbi[j] * uu[j]; }
            const float br = br2[0] + br2[1], bi = bi2[0] + bi2[1];
            const float nr = abr * xr - abi * xi + br, ni = abr * xi + abi * xr + bi;
            xr = nr; xi = ni;
            X[tt * 136 + lane] = f2bf(xr); X[tt * 136 + 64 + lane] = f2bf(xi);
        }
        wave_lds_fence();
#pragma unroll
        for (int rt = 0; rt < 2; ++rt) {
            f32x4 acc = {0.f, 0.f, 0.f, 0.f};
#pragma unroll
            for (int ks = 0; ks < 4; ++ks) { const bf16x8 a = *(const bf16x8*)(X + (rt * 16 + l15) * 136 + ks * 32 + quad * 8); acc = MFMA16(a, Cf[ks], acc); }
#pragma unroll
            for (int jj = 0; jj < 4; ++jj) { const int tt = rt * 16 + quad * 4 + jj;
                const float y = acc[jj] + dsk * U[tt * 16 + l15];
                const float gl = 0.5f * y * (1.0f + tanhf_(0.7978845608028654f * (y + 0.044715f * y * y * y)));
                Cp[(size_t)(t0 + tt) * 512 + l15] = f2bf(gl); }
        }
        wave_lds_fence();
    }
}


#ifdef DBG_STOP
__device__ __forceinline__ void phase_dump(const int tid, const int bid, const int gsz, const Params& p, int mode) {
    const int lane = tid & 63, wid = tid >> 6;
    const bf16_t* Pj = (const bf16_t*)(p.ws + P_OFF); const bf16_t* Cp = (const bf16_t*)(p.ws + CPRE_OFF); const bf16_t* Xb = (const bf16_t*)(p.ws + XBF_OFF);
    const bf16_t* Mg = (const bf16_t*)(p.ws + MG_OFF);
    for (int row = bid * 8 + wid; row < T_; row += gsz * 8) {
        float v[16];
#pragma unroll
        for (int j = 0; j < 16; ++j) { const int c = lane + 64 * j; float a = 0.f;
            if (mode == 1) { for (int k = 0; k < 5; ++k) a += bf2f(Pj[(size_t)row * PW + c + 1024 * k]); a += bf2f(Pj[(size_t)row * PW + 5120 + (c & 255)]); }
            if (mode == 2) { const bf16_t* Y = (const bf16_t*)p.out; a = bf2f(Y[(size_t)row * 2048 + c]) + bf2f(Y[(size_t)row * 2048 + 1024 + (c & 511)]) + bf2f(Cp[(size_t)row * 512 + (c & 511)]); }
            if (mode == 3) { const bf16_t* Y = (const bf16_t*)p.out; a = bf2f(Y[(size_t)row * 2048 + 1024 + c]) + bf2f(Pj[(size_t)row * 3072 + c]) + bf2f(Pj[(size_t)row * 3072 + 1024 + c]) + bf2f(Pj[(size_t)row * 3072 + 2048 + c]); }
            if (mode == 21) { const bf16_t* Y = (const bf16_t*)p.out; a = bf2f(Y[(size_t)row * 2048 + (c & 511)]); }
            if (mode == 22) { const bf16_t* Y = (const bf16_t*)p.out; a = bf2f(Y[(size_t)row * 2048 + 512 + c]); }
            if (mode == 23) a = bf2f(Cp[(size_t)row * 512 + (c & 511)]);
            if (mode == 4) a = bf2f(Mg[(size_t)row * 1024 + c]);
            if (mode == 5) a = p.out[(size_t)row * 1024 + c];
            if (mode == 6) a = bf2f(Xb[(size_t)row * 1024 + c]);
            if (mode == 7) { for (int k = 0; k < 4; ++k) a += bf2f(Pj[(size_t)row * 4096 + c + 1024 * k]); }
            v[j] = a; }
        asm volatile("s_waitcnt vmcnt(0)" ::: "memory");
#pragma unroll
        for (int j = 0; j < 16; ++j) p.out[(size_t)row * 1024 + lane + 64 * j] = v[j];
    }
}
#endif
constexpr int PH_PER_LAYER = 10, N_PHASES = 2 * PH_PER_LAYER;
typedef const __attribute__((address_space(4))) Params* KP;
template <int PHC> __device__ __forceinline__ void run_phase(KP kp, unsigned char* smem) {
    int ph = PHC;
    int tid = threadIdx.x; asm volatile("" : "+v"(tid));
    int bid = blockIdx.x, gsz = gridDim.x;
    asm volatile("" : "+s"(kp), "+s"(bid), "+s"(gsz));
    Params p;
    { const __attribute__((address_space(4))) unsigned long long* s_ = (const __attribute__((address_space(4))) unsigned long long*)kp;
#define PIN_(i) ((const float*)(const __attribute__((address_space(1))) float*)s_[i])
      p.x = PIN_(0);
      p.w_in = PIN_(1);
      p.b_gate = PIN_(2);
      p.a_shift = PIN_(3);
      p.a_w0 = PIN_(4);
      p.a_w2 = PIN_(5);
      p.a_a0 = PIN_(6);
      p.a_a2 = PIN_(7);
      p.a_g2 = PIN_(8);
      p.a_kk = PIN_(9);
      p.a_ka = PIN_(10);
      p.a_rk = PIN_(11);
      p.a_lnx_g = PIN_(12);
      p.a_lnx_b = PIN_(13);
      p.c_lam_re = PIN_(14);
      p.c_lam_im = PIN_(15);
      p.c_log_dt = PIN_(16);
      p.c_b_re = PIN_(17);
      p.c_b_im = PIN_(18);
      p.c_c_re = PIN_(19);
      p.c_c_im = PIN_(20);
      p.c_d = PIN_(21);
      p.c_w_glu = PIN_(22);
      p.c_b_glu = PIN_(23);
      p.w_branch = PIN_(24);
      p.w_out = PIN_(25);
      p.ln1_g = PIN_(26);
      p.ln1_b = PIN_(27);
      p.w_ff1 = PIN_(28);
      p.w_ff2 = PIN_(29);
      p.ln2_g = PIN_(30);
      p.ln2_b = PIN_(31);
#undef PIN_
      p.out = (float*)(__attribute__((address_space(1))) float*)s_[32];
      p.ws = (unsigned char*)(__attribute__((address_space(1))) unsigned char*)s_[33]; }
    constexpr int l = PHC / PH_PER_LAYER, q = PHC % PH_PER_LAYER;
    bf16_t* W = (bf16_t*)(p.ws + W_OFF + (size_t)l * 40 * MiB);
    bf16_t* Xbf = (bf16_t*)(p.ws + XBF_OFF);
    bf16_t* Pj = (bf16_t*)(p.ws + P_OFF);
    bf16_t* Gt = (bf16_t*)(p.ws + GT_OFF);
    bf16_t* Mg = (bf16_t*)(p.ws + MG_OFF);
    bf16_t* Hb = (bf16_t*)(p.ws + H_OFF);
    bf16_t* Cp = (bf16_t*)(p.ws + CPRE_OFF);
    bf16_t* Yb = (bf16_t*)p.out;
    bf16_t* Pre = (bf16_t*)(p.ws + PRE_OFF);
#ifdef ONLY_Q
    if (q != ONLY_Q) return;
#endif
#ifdef DBG_STOP
    if (ph == DBG_STOP) { phase_dump(tid, bid, gsz, p, DBG_MODE); return; }
    if (ph > DBG_STOP) return;
#endif
    switch (q) {
    case 0: if (l == 0) phase_convert(tid, bid, gsz, p, 0, smem, 3); break;
    case 1: { EpiStore E; E.O = Pj; E.ldc = PW; run_gemm(tid, bid, gsz, smem, Xbf, 1024, W + WT_IN, 1024, PW, 1024, E); } break;
    case 2:
        for (int item = bid; item < 256; item += gsz) {
            asm volatile("" : "+v"(tid));
#ifdef ONLY_MIX
            if (ONLY_MIX == 0) rwkv_item(tid, p, l, item >> 3, item & 7, smem);
            if (ONLY_MIX == 1) ret_item(tid, p, l, (item - 128) >> 2, (item - 128) & 3, smem);
            if (ONLY_MIX == 2) { const int bg = (item - 192) * 8 + (tid >> 6); s5_wave(tid, p, l, bg >> 5, bg & 31, smem + (tid >> 6) * 10752); }
#else
            if (item < 128) rwkv_item(tid, p, l, item >> 3, item & 7, smem);
            else if (item < 192) ret_item(tid, p, l, (item - 128) >> 2, (item - 128) & 3, smem);
            else { const int bg = (item - 192) * 8 + (tid >> 6); s5_wave(tid, p, l, bg >> 5, bg & 31, smem + (tid >> 6) * 10752); }
#endif
            __syncthreads();
        }
        if (gsz == 256) { if (bid >= 128) phase_convert(tid, bid - 128, 128, p, 1, smem, (l == 0) ? 1 : 2); }
        else if (l == 0) phase_convert(tid, bid, gsz, p, 1, smem, 3);
        break;
    case 3: {
        EpiGlu E; E.O = Yb; E.ldc = 2048; E.ocol0 = 1536; E.Yin = Cp; E.ldy = 512; E.bias = p.c_b_glu + l * 512;
        run_gemm(tid, bid, gsz, smem, Cp, 512, W + WT_GLU, 512, 512, 512, E);
        EpiSigmoid E2; E2.O = Gt; E2.ldc = 3072; E2.bias = p.b_gate + l * 3072;
        run_gemm(tid, bid, gsz, smem, Xbf, 1024, W + WT_IN + (size_t)PW * 1024, 1024, 3072, 1024, E2);
    } break;
    case 4: { EpiMerge E; E.O = Mg; E.G = Gt; run_gemm(tid, bid, gsz, smem, Yb, 2048, W + WT_BR, 2048, 1024, 2048, E); } break;
    case 5: { EpiResid E; E.C = Pre; E.X = Xbf; run_gemm(tid, bid, gsz, smem, Mg, 1024, W + WT_OUT, 1024, 1024, 1024, E); } break;
    case 6: phase_ln(tid, bid, gsz, Pre, p.ln1_g + l * 1024, p.ln1_b + l * 1024, Xbf, nullptr); break;
    case 7: { EpiSqRelu E; E.O = Hb; E.ldc = 4096; run_gemm(tid, bid, gsz, smem, Xbf, 1024, W + WT_FF1, 1024, 4096, 1024, E); } break;
    case 8: { EpiResid E; E.C = Pre; E.X = Xbf; run_gemm(tid, bid, gsz, smem, Hb, 4096, W + WT_FF2, 4096, 1024, 4096, E); } break;
    case 9: phase_ln(tid, bid, gsz, Pre, p.ln2_g + l * 1024, p.ln2_b + l * 1024, Xbf, (l == 1) ? p.out : nullptr); break;
    }
}

template <int LO, int HI> __device__ __forceinline__ void run_range(KP kp, unsigned char* smem, const XcdBarrier& xb) {
    if constexpr (LO < HI) {
        run_phase<LO>(kp, smem);
        if constexpr (LO + 1 < HI) {
            if constexpr (LO != PH_PER_LAYER) xcd_barrier(xb);
            run_range<LO + 1, HI>(kp, smem, xb);
        }
    }
}
__global__ void __launch_bounds__(512, 2) mega_fwd(Params p) {
    extern __shared__ __attribute__((aligned(16))) unsigned char smem[];
    KP kp = (KP)__builtin_amdgcn_kernarg_segment_ptr();
    volatile LAS unsigned* st = (volatile LAS unsigned*)((LAS unsigned char*)smem + LDS_BYTES - 16);
    if (threadIdx.x == 0) { st[0] = 0u; st[1] = 0u; }
    __syncthreads();
    const XcdBarrier xb = xcd_barrier_post((unsigned*)(p.ws + BAR_OFF), st);
    if (p.ws == nullptr) cg::this_grid().sync();
    run_range<0, N_PHASES>(kp, smem, xb);
}
#if MK_MULTI
template <int PH> __global__ void __launch_bounds__(512, 2) phase_kernel(Params p) {
    extern __shared__ __attribute__((aligned(16))) unsigned char smem[];
    KP kp = (KP)__builtin_amdgcn_kernarg_segment_ptr();
    run_phase<PH>(kp, smem);
}
template <int PH> static void launch_phases(int grid, const Params& p, hipStream_t stream) {
    if constexpr (PH < N_PHASES) {
        (void)hipFuncSetAttribute((const void*)phase_kernel<PH>, hipFuncAttributeMaxDynamicSharedMemorySize, LDS_BYTES);
        hipLaunchKernelGGL(phase_kernel<PH>, dim3(grid), dim3(512), LDS_BYTES, stream, p);
        launch_phases<PH + 1>(grid, p, stream);
    }
}
#endif

extern "C" void kernel_launch(void* const* d_in, const int* in_sizes, int n_in, void* d_out, int out_size, void* d_ws, size_t ws_size, hipStream_t stream) {
    static int grid = 0;
    if (grid == 0) {
        int dev = 0, cus = 0, per_cu = 0;
        if (n_in != 32 || out_size != T_ * D_ || ws_size < WS_END) { fprintf(stderr, "kernel_launch: unexpected problem (n_in %d, out %d, ws %zu)\n", n_in, out_size, ws_size); grid = -1; return; }
        hipGetDevice(&dev);
        hipDeviceGetAttribute(&cus, hipDeviceAttributeMultiprocessorCount, dev);
        if (hipFuncSetAttribute((const void*)mega_fwd, hipFuncAttributeMaxDynamicSharedMemorySize, LDS_BYTES) != hipSuccess) fprintf(stderr, "kernel_launch: hipFuncSetAttribute failed\n");
        hipOccupancyMaxActiveBlocksPerMultiprocessor(&per_cu, (const void*)mega_fwd, 512, LDS_BYTES);
        (void)hipGetLastError();
        if (per_cu < 1) { fprintf(stderr, "kernel_launch: occupancy query says %d\n", per_cu); per_cu = 1; }
        grid = cus;
    }
    if (grid < 0) return;
    Params p{};
    const float** pp = (const float**)&p;
    for (int i = 0; i < 32; ++i) pp[i] = (const float*)d_in[i];
    p.out = (float*)d_out; p.ws = (unsigned char*)d_ws;
#if MK_MULTI
    launch_phases<0>(grid, p, stream);
#else
    (void)hipMemsetAsync((unsigned char*)d_ws + BAR_OFF, 0, XCD_BAR_WORDS * sizeof(unsigned), stream);
    void* args[] = {&p};
    hipError_t e = hipLaunchCooperativeKernel((const void*)mega_fwd, dim3(grid), dim3(512), args, LDS_BYTES, stream);
    if (e != hipSuccess) fprintf(stderr, "cooperative launch failed: %s (grid %d)\n", hipGetErrorString(e), grid);
#endif
}
```
